# Optimizing an MI355X kernel written in HIP

```python
import math
import jax, jax.numpy as jnp
from jax import lax
import numpy as np

D_MODEL = 1024
BATCH = 8
SEQ = 4096
DEPTH = 1

CHUNK = 64
Q_BLOCK = 128
CONV_WIDTH = 31
D_CONV = D_MODEL // 2
N_HEADS = 4
HEAD_DIM = 64
V_DIM = 2 * HEAD_DIM
D_ATTN = N_HEADS * V_DIM
D_QK = N_HEADS * 2 * HEAD_DIM
N_BRANCH = 2
EPS = 1e-6
IN_GROUPS = (2 * D_CONV, D_CONV, D_QK, D_QK, D_ATTN, D_ATTN, N_BRANCH * D_MODEL)
D_IN = 2 * D_CONV + D_CONV + 2 * D_QK + 2 * D_ATTN + N_BRANCH * D_MODEL

kernel_name = "hybrid_conformer_conv_diff_attn_gated_block"


def rmsnorm(x, g):
    x32 = x.astype(jnp.float32)
    y = x32 * lax.rsqrt(jnp.mean(x32 * x32, axis=-1, keepdims=True) + EPS)
    return (y * g.astype(jnp.float32)).astype(x.dtype)


def layernorm(x, g, b):
    x32 = x.astype(jnp.float32)
    mu = jnp.mean(x32, axis=-1, keepdims=True)
    var = jnp.mean(jnp.square(x32 - mu), axis=-1, keepdims=True)
    y = (x32 - mu) * lax.rsqrt(var + EPS)
    return (y * g.astype(jnp.float32) + b.astype(jnp.float32)).astype(x.dtype)


def split_cols(proj):
    pts = np.cumsum(np.array(IN_GROUPS[:-1])).tolist()
    return jnp.split(proj, pts, axis=-1)


def conv_branch(u, z, w_dw, b_dw, ln_g, ln_b, w_proj):
    a, b = jnp.split(u, 2, axis=-1)
    h = a * jax.nn.sigmoid(b)
    hp = jnp.pad(h, ((0, 0), (CONV_WIDTH - 1, 0), (0, 0)))
    h = lax.conv_general_dilated(
        hp, w_dw[:, None, :].astype(h.dtype), window_strides=(1,), padding='VALID',
        dimension_numbers=('NWC', 'WIO', 'NWC'), feature_group_count=D_CONV) + b_dw
    h = jax.nn.silu(layernorm(h, ln_g, ln_b))
    h = h * jax.nn.silu(z)
    return h @ w_proj


def diff_attention(q, k, v, lam, lambda_init, sub_g):
    B, S = q.shape[0], q.shape[1]
    nblk = S // Q_BLOCK
    scale = 1.0 / math.sqrt(HEAD_DIM)
    slopes = 2.0 ** (-8.0 * jnp.arange(1, N_HEADS + 1, dtype=jnp.float32) / N_HEADS)
    s_pos = jnp.arange(S)
    qb = q.reshape(B, nblk, Q_BLOCK, N_HEADS, 2, HEAD_DIM).transpose(1, 0, 2, 3, 4, 5)

    def one_block(args):
        qi, i = args
        t_pos = i * Q_BLOCK + jnp.arange(Q_BLOCK)
        sc = jnp.einsum('bqhmd,bshmd->bhmqs', qi, k).astype(jnp.float32) * scale
        dist = jnp.abs(t_pos[:, None] - s_pos[None, :]).astype(jnp.float32)
        bias = -slopes[:, None, None, None] * dist[None, None]
        allowed = (s_pos[None, :] // CHUNK) <= (t_pos[:, None] // CHUNK)
        sc = jnp.where(allowed[None, None, None], sc + bias[None], -jnp.inf)
        p = jax.nn.softmax(sc, axis=-1)
        p = p[:, :, 0] - lam * p[:, :, 1]
        return jnp.einsum('bhqs,bshv->bqhv', p.astype(v.dtype), v)

    o = lax.map(one_block, (qb, jnp.arange(nblk)))
    o = o.transpose(1, 0, 2, 3, 4).reshape(B, S, N_HEADS, V_DIM)
    o = rmsnorm(o, sub_g) * (1.0 - lambda_init)
    return o.reshape(B, S, D_ATTN)


def setup_inputs(seed: int = 0) -> dict:
    key = jax.random.key(seed)
    ks = jax.random.split(key, 17)
    n = jax.random.normal
    L = DEPTH
    return {
        "x": n(ks[0], (BATCH, SEQ, D_MODEL), jnp.float32),
        "w_in": n(ks[1], (L, D_MODEL, D_IN), jnp.float32) * D_MODEL ** -0.5,
        "conv_w": n(ks[2], (L, CONV_WIDTH, D_CONV), jnp.float32) * CONV_WIDTH ** -0.5,
        "conv_b": n(ks[3], (L, D_CONV), jnp.float32) * 0.01,
        "conv_ln_g": 1.0 + 0.05 * n(ks[4], (L, D_CONV), jnp.float32),
        "conv_ln_b": 0.01 * n(ks[5], (L, D_CONV), jnp.float32),
        "w_conv_proj": n(ks[6], (L, D_CONV, D_MODEL), jnp.float32) * D_CONV ** -0.5,
        "lambda_q1": 0.1 * n(ks[7], (L, HEAD_DIM), jnp.float32),
        "lambda_k1": 0.1 * n(ks[8], (L, HEAD_DIM), jnp.float32),
        "lambda_q2": 0.1 * n(ks[9], (L, HEAD_DIM), jnp.float32),
        "lambda_k2": 0.1 * n(ks[10], (L, HEAD_DIM), jnp.float32),
        "subln_g": 1.0 + 0.05 * n(ks[11], (L, V_DIM), jnp.float32),
        "w_attn_proj": n(ks[12], (L, D_ATTN, D_MODEL), jnp.float32) * D_ATTN ** -0.5,
        "w_out": n(ks[13], (L, D_MODEL, D_MODEL), jnp.float32) * D_MODEL ** -0.5,
        "norm_pre_g": 1.0 + 0.05 * n(ks[14], (L, D_MODEL), jnp.float32),
        "norm_post_g": 1.0 + 0.05 * n(ks[15], (L, D_MODEL), jnp.float32),
    }


def reference(x, w_in, conv_w, conv_b, conv_ln_g, conv_ln_b, w_conv_proj,
              lambda_q1, lambda_k1, lambda_q2, lambda_k2, subln_g, w_attn_proj,
              w_out, norm_pre_g, norm_post_g):
    B, S, _ = x.shape
    for l in range(DEPTH):
        lambda_init = 0.8 - 0.6 * math.exp(-0.3 * l)
        h = rmsnorm(x, norm_pre_g[l])
        proj = h @ w_in[l]
        u_c, z_c, q, k, v, z_a, g = split_cols(proj)

        y_c = conv_branch(u_c, z_c, conv_w[l], conv_b[l], conv_ln_g[l], conv_ln_b[l], w_conv_proj[l])

        lam = (jnp.exp(jnp.sum(lambda_q1[l].astype(jnp.float32) * lambda_k1[l].astype(jnp.float32)))
               - jnp.exp(jnp.sum(lambda_q2[l].astype(jnp.float32) * lambda_k2[l].astype(jnp.float32)))
               + lambda_init)
        q = q.reshape(B, S, N_HEADS, 2, HEAD_DIM)
        k = k.reshape(B, S, N_HEADS, 2, HEAD_DIM)
        v = v.reshape(B, S, N_HEADS, V_DIM)
        o = diff_attention(q, k, v, lam, lambda_init, subln_g[l])
        y_a = (o * jax.nn.silu(z_a)) @ w_attn_proj[l]

        gates = jax.nn.sigmoid(g.reshape(B, S, N_BRANCH, D_MODEL))
        mixed = gates[:, :, 0] * y_c + gates[:, :, 1] * y_a
        out = mixed @ w_out[l]
        x = x + rmsnorm(out, norm_post_g[l])
    return x
```

```cpp
#include <hip/hip_runtime.h>
#include <hip/hip_cooperative_groups.h>
#include <cstdio>
#include <cstdint>
namespace cg = cooperative_groups;

namespace pg8 {
#define PG8_LAS __attribute__((address_space(3)))
typedef unsigned short bf16_t;
typedef short bf16x8 __attribute__((ext_vector_type(8)));
typedef float f32x4 __attribute__((ext_vector_type(4)));
typedef unsigned u32x4 __attribute__((ext_vector_type(4)));
constexpr int BM = 256, BK = 64, HALF = 128, HTB = HALF * BK * 2  , STAGE_BYTES = 8 * HTB, NXCD = 8, WGM = 8;

__host__ __device__ __forceinline__ int lds_byte(int r, int c) { const int st = (r >> 4) * 2 + (c >> 5), rr = r & 15, cc = c & 31, ob = rr * 64 + cc * 2; return st * 1024 + (ob ^ (((ob >> 9) & 1) << 5)); }
__host__ __device__ __forceinline__ void stage_rc(int b, int& R, int& C) { const int st = b / 1024, sb = b % 1024, swz = sb ^ (((sb >> 9) & 1) << 5); R = (st >> 1) * 16 + swz / 64; C = (st & 1) * 32 + (swz % 64) / 2; }
__host__ __device__ __forceinline__ int perm32(int rho) { const int n = rho >> 4, i = rho & 15; return 8 * (i >> 2) + 4 * n + (i & 3); }

struct Unit { int pm, pn; };
struct Gemm { const bf16_t* A; const bf16_t* Bt; int M, N, K; };

struct StaticOrder {
    int nM, nN, nwg, G, c;
    __host__ __device__ void init(int M, int N, int G_, int c_) { nM = M / BM; nN = N / BM; nwg = nM * nN; G = G_; c = c_; }
    __host__ __device__ bool next(int i, Unit& u) const {
        const long L = (long)i * G + c; if (L >= nwg) return false;
        int wgid = (int)L; { const int q = nwg / NXCD, r = nwg % NXCD, xcd = wgid % NXCD, off = wgid / NXCD; wgid = (xcd < r ? xcd * (q + 1) : r * (q + 1) + (xcd - r) * q) + off; }
        const int nig = WGM * nN, gid = wgid / nig, fm = gid * WGM, gsz = (nM - fm) < WGM ? (nM - fm) : WGM;
        u.pm = fm + ((wgid % nig) % gsz); u.pn = (wgid % nig) / gsz; return true;
    }
    __device__ __forceinline__ void a_ready(const Unit&) const {}
    __device__ __forceinline__ void done(const Unit&) const {}
};


__device__ __forceinline__ unsigned cvt_pk_bf16(float lo, float hi) { unsigned r; asm volatile("v_cvt_pk_bf16_f32 %0, %1, %2" : "=v"(r) : "v"(lo), "v"(hi)); return r; }
__device__ __forceinline__ float fsigmoid(float x) { return __builtin_amdgcn_rcpf(1.0f + __builtin_amdgcn_exp2f(-1.4426950408889634f * x)); }
__device__ __forceinline__ float bf_lo(unsigned w) { return __builtin_bit_cast(float, w << 16); }
__device__ __forceinline__ float bf_hi(unsigned w) { return __builtin_bit_cast(float, w & 0xffff0000u); }
constexpr int ACT_PITCH = 5120;
constexpr float QSCALE = 0.125f * 1.4426950408889634f;

struct EpiIn {
    static constexpr bool PERM = true, AFTER_DRAIN = false;
    bf16_t* ACT;
    __device__ __forceinline__ void operator()(const f32x4 (&acc)[2][2][4][2], const Unit& u, int wr, int wc, int fr, int fq) const {
        const int row0 = u.pm * BM + wr * 64 + fr; const int pn = u.pn;
        if (pn < 4) {
            const int col = pn * 128 + wc * 32 + 8 * fq;
#pragma unroll
            for (int ai = 0; ai < 2; ++ai)
#pragma unroll
                for (int m = 0; m < 4; ++m) {
                    bf16_t* p = ACT + (size_t)(row0 + ai * HALF + m * 16) * ACT_PITCH + col;
                    const f32x4 a0 = acc[ai][0][m][0], a1 = acc[ai][0][m][1], b0 = acc[ai][1][m][0], b1 = acc[ai][1][m][1];
                    u32x4 w;
                    w.x = cvt_pk_bf16(a0[0] * fsigmoid(b0[0]), a0[1] * fsigmoid(b0[1])); w.y = cvt_pk_bf16(a0[2] * fsigmoid(b0[2]), a0[3] * fsigmoid(b0[3]));
                    w.z = cvt_pk_bf16(a1[0] * fsigmoid(b1[0]), a1[1] * fsigmoid(b1[1])); w.w = cvt_pk_bf16(a1[2] * fsigmoid(b1[2]), a1[3] * fsigmoid(b1[3]));
                    *(u32x4*)p = w;
                }
        } else {
            const int act = (pn < 6) ? 1 : (pn < 8) ? 3 : (pn < 12) ? 0 : (pn < 14) ? 1 : 2;
            const int col = pn * 256 - 512 + wc * 32 + 8 * fq;
#pragma unroll
            for (int ai = 0; ai < 2; ++ai)
#pragma unroll
                for (int m = 0; m < 4; ++m) {
                    bf16_t* p = ACT + (size_t)(row0 + ai * HALF + m * 16) * ACT_PITCH + col;
#pragma unroll
                    for (int bj = 0; bj < 2; ++bj) {
                        f32x4 v0 = acc[ai][bj][m][0], v1 = acc[ai][bj][m][1];
                        if (act == 1) {
#pragma unroll
                            for (int j = 0; j < 4; ++j) { v0[j] = v0[j] * fsigmoid(v0[j]); v1[j] = v1[j] * fsigmoid(v1[j]); }
                        } else if (act == 2) {
#pragma unroll
                            for (int j = 0; j < 4; ++j) { v0[j] = fsigmoid(v0[j]); v1[j] = fsigmoid(v1[j]); }
                        } else if (act == 3) { v0 = v0 * QSCALE; v1 = v1 * QSCALE; }
                        u32x4 w; w.x = cvt_pk_bf16(v0[0], v0[1]); w.y = cvt_pk_bf16(v0[2], v0[3]); w.z = cvt_pk_bf16(v1[0], v1[1]); w.w = cvt_pk_bf16(v1[2], v1[3]);
                        *(u32x4*)(p + bj * HALF) = w;
                    }
                }
        }
    }
};

struct EpiMix {
    static constexpr bool PERM = true, AFTER_DRAIN = false;
    const bf16_t* ACT; bf16_t* MIX;
    __device__ __forceinline__ void mid(f32x4 (&acc)[2][2][4][2], const Unit& u, int wr, int wc, int fr, int fq) const {
        int row0 = u.pm * BM + wr * 64 + fr, col = u.pn * BM + wc * 32 + 8 * fq;
        asm volatile("" : "+v"(row0), "+v"(col));
#pragma unroll
        for (int ai = 0; ai < 2; ++ai)
#pragma unroll
            for (int m = 0; m < 4; ++m) {
                const bf16_t* g = ACT + (size_t)(row0 + ai * HALF + m * 16) * ACT_PITCH + 3072 + col;
#pragma unroll
                for (int bj = 0; bj < 2; ++bj) {
                    const u32x4 g0 = *(const u32x4*)(g + bj * HALF), g1 = *(const u32x4*)(g + 1024 + bj * HALF);
                    f32x4 r0, r1;
                    r0[0] = bf_lo(g0.x) * __builtin_amdgcn_rcpf(fmaxf(bf_lo(g1.x), 1e-20f)); r0[1] = bf_hi(g0.x) * __builtin_amdgcn_rcpf(fmaxf(bf_hi(g1.x), 1e-20f));
                    r0[2] = bf_lo(g0.y) * __builtin_amdgcn_rcpf(fmaxf(bf_lo(g1.y), 1e-20f)); r0[3] = bf_hi(g0.y) * __builtin_amdgcn_rcpf(fmaxf(bf_hi(g1.y), 1e-20f));
                    r1[0] = bf_lo(g0.z) * __builtin_amdgcn_rcpf(fmaxf(bf_lo(g1.z), 1e-20f)); r1[1] = bf_hi(g0.z) * __builtin_amdgcn_rcpf(fmaxf(bf_hi(g1.z), 1e-20f));
                    r1[2] = bf_lo(g0.w) * __builtin_amdgcn_rcpf(fmaxf(bf_lo(g1.w), 1e-20f)); r1[3] = bf_hi(g0.w) * __builtin_amdgcn_rcpf(fmaxf(bf_hi(g1.w), 1e-20f));
                    acc[ai][bj][m][0] = acc[ai][bj][m][0] * r0; acc[ai][bj][m][1] = acc[ai][bj][m][1] * r1;
                }
                asm volatile("" ::: "memory");
            }
    }
    __device__ __forceinline__ void operator()(const f32x4 (&acc)[2][2][4][2], const Unit& u, int wr, int wc, int fr, int fq) const {
        const int row0 = u.pm * BM + wr * 64 + fr, col = u.pn * BM + wc * 32 + 8 * fq;
#pragma unroll
        for (int ai = 0; ai < 2; ++ai)
#pragma unroll
            for (int m = 0; m < 4; ++m) {
                const size_t r = (size_t)(row0 + ai * HALF + m * 16);
                const bf16_t* g = ACT + r * ACT_PITCH + 4096 + col; bf16_t* p = MIX + r * 1024 + col;
#pragma unroll
                for (int bj = 0; bj < 2; ++bj) {
                    const u32x4 g1 = *(const u32x4*)(g + bj * HALF);
                    const f32x4 v0 = acc[ai][bj][m][0], v1 = acc[ai][bj][m][1];
                    u32x4 w;
                    w.x = cvt_pk_bf16(v0[0] * fmaxf(bf_lo(g1.x), 1e-20f), v0[1] * fmaxf(bf_hi(g1.x), 1e-20f)); w.y = cvt_pk_bf16(v0[2] * fmaxf(bf_lo(g1.y), 1e-20f), v0[3] * fmaxf(bf_hi(g1.y), 1e-20f));
                    w.z = cvt_pk_bf16(v1[0] * fmaxf(bf_lo(g1.z), 1e-20f), v1[1] * fmaxf(bf_hi(g1.z), 1e-20f)); w.w = cvt_pk_bf16(v1[2] * fmaxf(bf_lo(g1.w), 1e-20f), v1[3] * fmaxf(bf_hi(g1.w), 1e-20f));
                    *(u32x4*)(p + bj * HALF) = w;
                }
                asm volatile("" ::: "memory");
            }
    }
};

struct EpiOut {
    static constexpr bool PERM = false, AFTER_DRAIN = false;
    float* OUT; float* SUMSQ;
    __device__ __forceinline__ void operator()(const f32x4 (&acc)[2][2][4][2], const Unit& u, int wr, int wc, int fr, int fq) const {
        const int row0 = u.pm * BM + wr * 64 + fr, col0 = u.pn * BM + wc * 32 + 4 * fq;
#pragma unroll
        for (int ai = 0; ai < 2; ++ai)
#pragma unroll
            for (int m = 0; m < 4; ++m) {
                const int row = row0 + ai * HALF + m * 16; float* rowp = OUT + (size_t)row * 1024 + col0; float s = 0.f;
#pragma unroll
                for (int bj = 0; bj < 2; ++bj)
#pragma unroll
                    for (int n = 0; n < 2; ++n) { const f32x4 v = acc[ai][bj][m][n]; *(f32x4*)(rowp + bj * HALF + n * 16) = v; s += (v[0] * v[0] + v[1] * v[1]) + (v[2] * v[2] + v[3] * v[3]); }
                s += __shfl_xor(s, 16); s += __shfl_xor(s, 32);
                if (fq == 0) atomicAdd(SUMSQ + row, s);
            }
    }
};

template <class Epi, class Sched, bool ALIGN_EPI = false, bool SP2 = false, int MIDK = 0>
__device__ __forceinline__ void gemm_phase(PG8_LAS unsigned char* lds, const Gemm g, const Sched& S, const Epi& E) {
    const int tid = threadIdx.x, wid = __builtin_amdgcn_readfirstlane(tid >> 6), lane = tid & 63, wr = wid >> 2, wc = wid & 3, fr = lane & 15, fq = lane >> 4;
    const int K = g.K, nt = K / BK;
    unsigned voffA[2], voffB[2];
#pragma unroll
    for (int i = 0; i < 2; ++i) { int R, C; stage_rc(tid * 16 + i * 8192, R, C); const int Rb = Epi::PERM ? ((R & ~31) + perm32(R & 31)) : R;
        voffA[i] = (unsigned)(R * K + C) * 2u; voffB[i] = (unsigned)(Rb * K + C) * 2u; }
    const size_t kstep = (size_t)(BK * 2);
    const size_t hstep = (size_t)HALF * K * 2;
    const size_t tstep = 2 * hstep;
    const unsigned ldsw = (unsigned)wid * 1024u;
    const int aoff = lds_byte(wr * 64 + fr, fq * 8), boff = lds_byte(wc * 32 + fr, fq * 8);
#define PG8_SA(b, h) (((b) * 2 + (h)) * HTB)
#define PG8_SB(b, h) ((4 + (b) * 2 + (h)) * HTB)
#define PG8_STAGE(bufoff, gbase, voff) do { _Pragma("unroll") for (int _i = 0; _i < 2; ++_i) \
        __builtin_amdgcn_global_load_lds((const unsigned*)((const char*)(gbase) + (voff)[_i]), (PG8_LAS unsigned*)(lds + (bufoff) + ldsw + _i * 8192), 16, 0, 0); } while (0)
#define PG8_LDA(dst, b, h) do { _Pragma("unroll") for (int m = 0; m < 4; ++m) _Pragma("unroll") for (int k = 0; k < 2; ++k) dst[m][k] = *(const PG8_LAS bf16x8*)(lds + PG8_SA(b, h) + aoff + m * 2048 + k * 1024); } while (0)
#define PG8_LDB(dst, b, h) do { _Pragma("unroll") for (int n = 0; n < 2; ++n) _Pragma("unroll") for (int k = 0; k < 2; ++k) dst[n][k] = *(const PG8_LAS bf16x8*)(lds + PG8_SB(b, h) + boff + n * 2048 + k * 1024); } while (0)
#define PG8_MMA(ai, bj, At, Bt) do { __builtin_amdgcn_s_setprio(1); _Pragma("unroll") for (int m = 0; m < 4; ++m) _Pragma("unroll") for (int n = 0; n < 2; ++n) _Pragma("unroll") for (int k = 0; k < 2; ++k) \
        acc[ai][bj][m][n] = __builtin_amdgcn_mfma_f32_16x16x32_bf16(Bt[n][k], At[m][k], acc[ai][bj][m][n], 0, 0, 0); __builtin_amdgcn_s_setprio(0); } while (0)
#define PG8_WAIT_V(n) asm volatile("s_waitcnt vmcnt(" #n ")" ::: "memory")
#define PG8_WAIT_L(n) asm volatile("s_waitcnt lgkmcnt(" #n ")" ::: "memory")
#define PG8_BAR __builtin_amdgcn_s_barrier()
#define PG8_SCHED __builtin_amdgcn_sched_barrier(0)
    Unit cur, nxt; int ui = 0;
    if (!S.next(0, cur)) return;
    f32x4 acc[2][2][4][2];
#pragma unroll
    for (int a = 0; a < 2; ++a)
#pragma unroll
        for (int b = 0; b < 2; ++b)
#pragma unroll
            for (int m = 0; m < 4; ++m)
#pragma unroll
                for (int n = 0; n < 2; ++n) acc[a][b][m][n] = (f32x4){0.f, 0.f, 0.f, 0.f};
    bf16x8 At[4][2], B0[2][2], B1[2][2];
    const char* cA = (const char*)g.A + (size_t)cur.pm * tstep; const char* cB = (const char*)g.Bt + (size_t)cur.pn * tstep;
    S.a_ready(cur);
    if constexpr (SP2) {
        PG8_STAGE(PG8_SB(0, 0), cB, voffB); PG8_STAGE(PG8_SB(0, 1), cB + hstep, voffB); PG8_STAGE(PG8_SA(0, 0), cA, voffA); PG8_STAGE(PG8_SA(0, 1), cA + hstep, voffA);
        if (wr == 1) PG8_BAR;
        PG8_WAIT_V(2); PG8_BAR;
        PG8_STAGE(PG8_SB(1, 0), cB + kstep, voffB); PG8_STAGE(PG8_SA(1, 0), cA + kstep, voffA); PG8_STAGE(PG8_SB(1, 1), cB + hstep + kstep, voffB);
        PG8_WAIT_V(6); PG8_BAR;
    } else {
        PG8_STAGE(PG8_SB(0, 0), cB, voffB); PG8_STAGE(PG8_SA(0, 0), cA, voffA); PG8_STAGE(PG8_SB(0, 1), cB + hstep, voffB); PG8_STAGE(PG8_SA(0, 1), cA + hstep, voffA);
        if (wr == 1) PG8_BAR;
        PG8_WAIT_V(4); PG8_BAR;
        PG8_STAGE(PG8_SB(1, 0), cB + kstep, voffB); PG8_STAGE(PG8_SA(1, 0), cA + kstep, voffA); PG8_STAGE(PG8_SB(1, 1), cB + hstep + kstep, voffB);
        PG8_WAIT_V(6); PG8_BAR;
    }
    for (;;) {
        const bool has_next = S.next(ui + 1, nxt);
        const char* nA = has_next ? (const char*)g.A + (size_t)nxt.pm * tstep : cA; const char* nB = has_next ? (const char*)g.Bt + (size_t)nxt.pn * tstep : cB;
        for (int t = 0; t < nt; t += 2) {
            if constexpr (MIDK > 0) { if (t == MIDK) E.mid(acc, cur, wr, wc, fr, fq); }
            const bool last = (t == nt - 2);
            const char* a1 = cA + (size_t)(t + 1) * kstep;
            const char* a2 = last ? nA : cA + (size_t)(t + 2) * kstep; const char* b2 = last ? nB : cB + (size_t)(t + 2) * kstep;
            const char* a3 = a2 + kstep; const char* b3 = b2 + kstep;
            if (last && has_next) S.a_ready(nxt);
            if constexpr (SP2) {
            PG8_LDB(B0, 0, 0); PG8_LDB(B1, 0, 1); PG8_SCHED; PG8_LDA(At, 0, 0); PG8_STAGE(PG8_SA(1, 1), a1 + hstep, voffA);
            PG8_WAIT_V(8); PG8_WAIT_L(0); PG8_BAR; PG8_MMA(0, 0, At, B0); PG8_MMA(0, 1, At, B1); PG8_BAR; PG8_SCHED;
            PG8_LDA(At, 0, 1); PG8_STAGE(PG8_SB(0, 0), b2, voffB); PG8_STAGE(PG8_SB(0, 1), b2 + hstep, voffB); PG8_STAGE(PG8_SA(0, 0), a2, voffA);
            PG8_WAIT_V(8); PG8_WAIT_L(0); PG8_BAR; PG8_MMA(1, 0, At, B0); PG8_MMA(1, 1, At, B1); PG8_BAR; PG8_SCHED;
            PG8_LDB(B0, 1, 0); PG8_LDB(B1, 1, 1); PG8_SCHED; PG8_LDA(At, 1, 0); PG8_STAGE(PG8_SA(0, 1), a2 + hstep, voffA);
            PG8_WAIT_V(8); PG8_WAIT_L(0); PG8_BAR; PG8_MMA(0, 0, At, B0); PG8_MMA(0, 1, At, B1); PG8_BAR; PG8_SCHED;
            PG8_LDA(At, 1, 1); PG8_STAGE(PG8_SB(1, 0), b3, voffB); PG8_STAGE(PG8_SB(1, 1), b3 + hstep, voffB); PG8_STAGE(PG8_SA(1, 0), a3, voffA);
            PG8_WAIT_V(8); PG8_WAIT_L(0); PG8_BAR; PG8_MMA(1, 0, At, B0); PG8_MMA(1, 1, At, B1); PG8_BAR; PG8_SCHED;
            } else {
            PG8_LDB(B0, 0, 0); PG8_SCHED; PG8_LDA(At, 0, 0); PG8_STAGE(PG8_SA(1, 1), a1 + hstep, voffA);
            PG8_WAIT_L(8); PG8_BAR; PG8_WAIT_L(0); PG8_MMA(0, 0, At, B0); PG8_BAR; PG8_SCHED;
            PG8_LDB(B1, 0, 1); PG8_STAGE(PG8_SB(0, 0), b2, voffB);
            PG8_BAR; PG8_WAIT_L(0); PG8_MMA(0, 1, At, B1); PG8_BAR;
            PG8_LDA(At, 0, 1); PG8_STAGE(PG8_SA(0, 0), a2, voffA);
            PG8_BAR; PG8_WAIT_L(0); PG8_MMA(1, 0, At, B0); PG8_BAR; PG8_SCHED;
            PG8_STAGE(PG8_SB(0, 1), b2 + hstep, voffB);
            PG8_WAIT_V(6); PG8_BAR; PG8_MMA(1, 1, At, B1); PG8_BAR;
            PG8_LDB(B0, 1, 0); PG8_SCHED; PG8_LDA(At, 1, 0); PG8_STAGE(PG8_SA(0, 1), a2 + hstep, voffA);
            PG8_WAIT_L(8); PG8_BAR; PG8_WAIT_L(0); PG8_MMA(0, 0, At, B0); PG8_BAR; PG8_SCHED;
            PG8_LDB(B1, 1, 1); PG8_STAGE(PG8_SB(1, 0), b3, voffB);
            PG8_BAR; PG8_WAIT_L(0); PG8_MMA(0, 1, At, B1); PG8_BAR;
            PG8_LDA(At, 1, 1); PG8_STAGE(PG8_SA(1, 0), a3, voffA);
            PG8_BAR; PG8_WAIT_L(0); PG8_MMA(1, 0, At, B0); PG8_BAR; PG8_SCHED;
            PG8_STAGE(PG8_SB(1, 1), b3 + hstep, voffB);
            PG8_WAIT_V(6); PG8_BAR; PG8_MMA(1, 1, At, B1); PG8_BAR;
            }
        }
        if constexpr (ALIGN_EPI) { if (wr == 0) PG8_BAR; }
        if constexpr (!Epi::AFTER_DRAIN) { E(acc, cur, wr, wc, fr, fq); S.done(cur); }
        if (!has_next) break;
#pragma unroll
        for (int a = 0; a < 2; ++a)
#pragma unroll
            for (int b = 0; b < 2; ++b)
#pragma unroll
                for (int m = 0; m < 4; ++m)
#pragma unroll
                    for (int n = 0; n < 2; ++n) acc[a][b][m][n] = (f32x4){0.f, 0.f, 0.f, 0.f};
        cur = nxt; cA = nA; cB = nB; ++ui;
        if constexpr (ALIGN_EPI) { if (wr == 1) PG8_BAR; }
    }
    PG8_WAIT_V(0);
    if constexpr (!ALIGN_EPI) { if (wr == 0) PG8_BAR; }
    PG8_BAR;
    if constexpr (Epi::AFTER_DRAIN) { E.fused(acc, cur, wr, wc, fr, fq, lds, wid, lane); S.done(cur); }
#undef PG8_SA
#undef PG8_SB
#undef PG8_STAGE
#undef PG8_LDA
#undef PG8_LDB
#undef PG8_MMA
#undef PG8_WAIT_V
#undef PG8_WAIT_L
#undef PG8_BAR
#undef PG8_SCHED
}
}

#define LAS __attribute__((address_space(3)))
typedef unsigned short bf16;
typedef short bf16x8 __attribute__((ext_vector_type(8)));
typedef short s16x4 __attribute__((ext_vector_type(4)));
typedef float f32x4 __attribute__((ext_vector_type(4)));
typedef float f32x16 __attribute__((ext_vector_type(16)));
typedef unsigned u32x4 __attribute__((ext_vector_type(4)));
typedef unsigned u32x2 __attribute__((ext_vector_type(2)));

constexpr int NB = 8, SEQ = 4096, DM = 1024, TOK = NB * SEQ;
constexpr int DCONV = 512, CW = 31, NH = 4, DIN = 5632, PITCH = pg8::ACT_PITCH;
constexpr int C_HG = 0, C_ZC = 512, C_Q = 1024, C_K = 1536, C_V = 2048, C_ZA = 2560, C_G0 = 3072, C_G1 = 4096;
constexpr float EPS = 1e-6f, LAMBDA_INIT = 0.2f, LOG2E = 1.4426950408889634f;
constexpr size_t MiB = 1u << 20;
constexpr size_t WS_CTL = 0, CTL_ZERO_BYTES = 1 * MiB;
constexpr size_t WS_SUMSQ = 256 * 1024;
constexpr size_t WS_WIN = 2 * MiB;
constexpr size_t WS_WBR = 14 * MiB;
constexpr size_t WS_WO = 16 * MiB;
constexpr size_t WS_XN = 32 * MiB;
constexpr size_t WS_ACT = 96 * MiB;
constexpr size_t WS_A2 = 416 * MiB;
constexpr size_t WS_END = 480 * MiB;
constexpr int LDS_BYTES = 131072 + 1024;

__device__ __forceinline__ float wave_sum(float v) {
#pragma unroll
    for (int o = 1; o < 64; o <<= 1) v += __shfl_xor(v, o);
    return v;
}
__device__ __forceinline__ unsigned pk2(float lo, float hi) { return pg8::cvt_pk_bf16(lo, hi); }
using pg8::bf_lo; using pg8::bf_hi; using pg8::fsigmoid;

__device__ __forceinline__ void p0_transpose_item(const float* W, int N, int k0, int n0, bf16* WT, int drow0, int ldk, int koff, const float* kscale, LAS float* scr, int lane) {
#pragma unroll 8
    for (int i = 0; i < 32; ++i) { const int kk = 2 * i + (lane >> 5); float v = W[(size_t)(k0 + kk) * N + n0 + (lane & 31)]; if (kscale) v *= kscale[k0 + kk]; scr[kk * 33 + (lane & 31)] = v; }
    asm volatile("s_waitcnt lgkmcnt(0)" ::: "memory");
    const int c = lane & 7;
#pragma unroll
    for (int j = 0; j < 4; ++j) { const int n = (lane >> 3) + 8 * j; const LAS float* s = scr + (8 * c) * 33 + n;
        u32x4 o; o.x = pk2(s[0 * 33], s[1 * 33]); o.y = pk2(s[2 * 33], s[3 * 33]); o.z = pk2(s[4 * 33], s[5 * 33]); o.w = pk2(s[6 * 33], s[7 * 33]);
        *(u32x4*)(WT + (size_t)(drow0 + n) * ldk + koff + k0 + 8 * c) = o; }
    asm volatile("s_waitcnt lgkmcnt(0)" ::: "memory");
}
struct P0Args { const float *x, *w_in, *w_cp, *w_ap, *w_out, *g_pre, *lq1, *lk1, *lq2, *lk2; bf16 *WIN, *WBR, *WO, *XN; float* lam; };
__device__ __forceinline__ void p0_prologue(const P0Args& a, LAS unsigned char* lds, int wave, int lane, int G) {
    LAS float* scr = (LAS float*)(lds + wave * 16384);
    const int gw = blockIdx.x * 8 + wave, NGW = G * 8;
    constexpr int I_IN = (DM / 64) * (DIN / 32), I_CP = (DCONV / 64) * (DM / 32), I_AP = I_CP, I_O = (DM / 64) * (DM / 32);
    constexpr int NITEMS = I_IN + I_CP + I_AP + I_O;
    for (int it = gw; it < NITEMS; it += NGW) {
        int r = it;
        if (r < I_IN) { const int nblk = DIN / 32, kb = r / nblk, nb = r % nblk, n0 = 32 * nb;
            int d0 = n0; if (n0 < 1024) { const int bjj = n0 >> 9, ch = n0 & 511; d0 = 256 * (ch >> 7) + 128 * bjj + (ch & 127); }
            p0_transpose_item(a.w_in, DIN, 64 * kb, n0, a.WIN, d0, DM, 0, a.g_pre, scr, lane); continue; }
        r -= I_IN;
        if (r < I_CP) { const int nblk = DM / 32, kb = r / nblk, nb = r % nblk; p0_transpose_item(a.w_cp, DM, 64 * kb, 32 * nb, a.WBR, 32 * nb, DM, 0, nullptr, scr, lane); continue; }
        r -= I_CP;
        if (r < I_AP) { const int nblk = DM / 32, kb = r / nblk, nb = r % nblk; p0_transpose_item(a.w_ap, DM, 64 * kb, 32 * nb, a.WBR, 32 * nb, DM, 512, nullptr, scr, lane); continue; }
        r -= I_AP;
        { const int nblk = DM / 32, kb = r / nblk, nb = r % nblk; p0_transpose_item(a.w_out, DM, 64 * kb, 32 * nb, a.WO, 32 * nb, DM, 0, nullptr, scr, lane); }
    }
    for (int m = gw; m < TOK; m += NGW) {
        const f32x4* xr = (const f32x4*)(a.x + (size_t)m * DM) + lane;
        f32x4 v[4]; float s = 0.f;
#pragma unroll
        for (int j = 0; j < 4; ++j) { v[j] = xr[64 * j]; s += (v[j][0] * v[j][0] + v[j][1] * v[j][1]) + (v[j][2] * v[j][2] + v[j][3] * v[j][3]); }
        const float rstd = 1.0f / sqrtf(wave_sum(s) * (1.0f / DM) + EPS);
        u32x2* o8 = (u32x2*)(a.XN + (size_t)m * DM) + lane;
#pragma unroll
        for (int j = 0; j < 4; ++j) { u32x2 w; w.x = pk2(v[j][0] * rstd, v[j][1] * rstd); w.y = pk2(v[j][2] * rstd, v[j][3] * rstd); o8[64 * j] = w; }
    }
    if (blockIdx.x == 0 && wave == 0) {
        const float s1 = wave_sum(a.lq1[lane] * a.lk1[lane]), s2 = wave_sum(a.lq2[lane] * a.lk2[lane]);
        if (lane == 0) a.lam[0] = expf(s1) - expf(s2) + LAMBDA_INIT;
    }
}

struct ConvArgs { const bf16* ACT; bf16* A2; const float *cw, *cb, *lng, *lnb; };
__device__ __forceinline__ void conv_phase(const ConvArgs& a, LAS unsigned char* lds, int wave, int lane, int G) {
    const int tid = threadIdx.x;
    LAS bf16* IN = (LAS bf16*)lds;
    LAS float* CV = (LAS float*)(lds + 65536);
    float w[CW];
#pragma unroll
    for (int j = 0; j < CW; ++j) w[j] = a.cw[j * DCONV + tid];
    const float cb = a.cb[tid];
    for (int u = blockIdx.x; u < TOK / 32; u += G) {
        const int b = u / (SEQ / 32), t0 = (u % (SEQ / 32)) * 32; const size_t rowbase = (size_t)b * SEQ;
        for (int p = tid; p < 62 * 64; p += 512) { const int row = p >> 6, c = p & 63, tt = t0 - 30 + row;
            u32x4 v = (u32x4){0u, 0u, 0u, 0u};
            if (tt >= 0) v = *(const u32x4*)(a.ACT + (rowbase + tt) * PITCH + C_HG + c * 8);
            *(LAS u32x4*)(IN + row * 512 + c * 8) = v; }
        __syncthreads();
#pragma unroll 1
        for (int g = 0; g < 4; ++g) {
            float xin[38];
#pragma unroll
            for (int i = 0; i < 38; ++i) xin[i] = __builtin_bit_cast(float, (unsigned)IN[(8 * g + i) * 512 + tid] << 16);
#pragma unroll
            for (int tk = 0; tk < 8; ++tk) { float acc = cb;
#pragma unroll
                for (int j = 0; j < CW; ++j) acc = __builtin_fmaf(xin[tk + j], w[j], acc);
                CV[(8 * g + tk) * 512 + tid] = acc; }
        }
        __syncthreads();
#pragma unroll 1
        for (int i = 0; i < 4; ++i) {
            const int tl = wave * 4 + i; const size_t row = rowbase + t0 + tl; const int c0 = lane * 8;
            const f32x4 v0 = *(const LAS f32x4*)(CV + tl * 512 + c0), v1 = *(const LAS f32x4*)(CV + tl * 512 + c0 + 4);
            const float mean = wave_sum((v0[0] + v0[1]) + (v0[2] + v0[3]) + (v1[0] + v1[1]) + (v1[2] + v1[3])) * (1.0f / DCONV);
            const f32x4 d0 = v0 - mean, d1 = v1 - mean;
            const float var = wave_sum((d0[0] * d0[0] + d0[1] * d0[1]) + (d0[2] * d0[2] + d0[3] * d0[3]) + (d1[0] * d1[0] + d1[1] * d1[1]) + (d1[2] * d1[2] + d1[3] * d1[3])) * (1.0f / DCONV);
            const float rstd = 1.0f / sqrtf(var + EPS);
            const f32x4 g0 = *(const f32x4*)(a.lng + c0), g1 = *(const f32x4*)(a.lng + c0 + 4), b0 = *(const f32x4*)(a.lnb + c0), b1 = *(const f32x4*)(a.lnb + c0 + 4);
            const u32x4 z = *(const u32x4*)(a.ACT + row * PITCH + C_ZC + c0);
            f32x4 y0 = d0 * rstd * g0 + b0, y1 = d1 * rstd * g1 + b1;
#pragma unroll
            for (int j = 0; j < 4; ++j) { y0[j] = y0[j] * fsigmoid(y0[j]); y1[j] = y1[j] * fsigmoid(y1[j]); }
            u32x4 o;
            o.x = pk2(y0[0] * bf_lo(z.x), y0[1] * bf_hi(z.x)); o.y = pk2(y0[2] * bf_lo(z.y), y0[3] * bf_hi(z.y));
            o.z = pk2(y1[0] * bf_lo(z.z), y1[1] * bf_hi(z.z)); o.w = pk2(y1[2] * bf_lo(z.w), y1[3] * bf_hi(z.w));
            *(u32x4*)(a.A2 + row * DM + c0) = o;
        }
        __syncthreads();
    }
}

struct AttArgs { const bf16* ACT; bf16* A2; const float* subg; const float* lam; };
namespace att {
constexpr int KBYTES = 16384, BUF = 32768;
__device__ __forceinline__ int crow(int r, int hi) { return (r & 3) + 8 * (r >> 2) + 4 * hi; }
__device__ __forceinline__ s16x4 vtr(const LAS unsigned char* p) { typedef short v4i16_t __attribute__((ext_vector_type(4))); return __builtin_bit_cast(s16x4, __builtin_amdgcn_ds_read_tr16_b64_v4i16((LAS v4i16_t*)p)); }

__device__ __forceinline__ void unit(const AttArgs& a, int b, int h, int qb, float lam, LAS unsigned char* lds) {
    const int tid = threadIdx.x, lane = tid & 63, w = __builtin_amdgcn_readfirstlane(tid >> 6), r32 = lane & 31, hi = lane >> 5;
    const int mp = w >> 2, wq = w & 3;
    const size_t rowbase = (size_t)b * SEQ;
    const int tq = qb * 128 + wq * 32 + r32;
    const int cw = 2 * qb + (wq >> 1);
    const float sig = __builtin_amdgcn_exp2f(-2.0f * (float)(h + 1)) * LOG2E;
    bf16x8 qr[4];
    { const bf16* Qp = a.ACT + (rowbase + tq) * PITCH + C_Q + h * 128 + mp * 64 + hi * 8;
#pragma unroll
      for (int d0 = 0; d0 < 4; ++d0) qr[d0] = *(const bf16x8*)(Qp + 16 * d0); }
    const int prow = tid >> 4, pch = tid & 15;
    const bf16* Ksrc = a.ACT + (rowbase + prow) * PITCH + C_K + h * 128 + pch * 8;
    const bf16* Vsrc = a.ACT + (rowbase + prow) * PITCH + C_V + h * 128 + pch * 8;
    const int kdst = (pch >> 3) * 8192 + ((pch & 7) >> 1) * 2048 + (pch & 1) * 1024 + prow * 16;
    const int vdst = KBYTES + (pch >> 2) * 4096 + prow * 64 + (pch & 3) * 16;
    u32x4 kst[2], vst[2];
#define ATT_LOAD(j) do { _Pragma("unroll") for (int i_ = 0; i_ < 2; ++i_) { kst[i_] = *(const u32x4*)(Ksrc + (size_t)(64 * (j) + 32 * i_) * PITCH); vst[i_] = *(const u32x4*)(Vsrc + (size_t)(64 * (j) + 32 * i_) * PITCH); } } while (0)
#define ATT_WRITE(bufo) do { _Pragma("unroll") for (int i_ = 0; i_ < 2; ++i_) { *(LAS u32x4*)(lds + (bufo) + kdst + i_ * 512) = kst[i_]; *(LAS u32x4*)(lds + (bufo) + vdst + i_ * 2048) = vst[i_]; } } while (0)
    float m = -INFINITY, l = 0.f;
    f32x16 o[4];
#pragma unroll
    for (int i = 0; i < 4; ++i)
#pragma unroll
        for (int r = 0; r < 16; ++r) o[i][r] = 0.f;
    const int jmax = 2 * qb + 1;
    ATT_LOAD(jmax); ATT_WRITE(0); __syncthreads();
    int cur = 0;
    for (int j = jmax; j >= 0; --j) {
        if (j > 0) ATT_LOAD(j - 1);
        if (j <= cw) {
            const LAS unsigned char* Kb = lds + cur * BUF + mp * 8192 + hi * 1024 + r32 * 16;
            f32x16 p0, p1;
#pragma unroll
            for (int r = 0; r < 16; ++r) { p0[r] = 0.f; p1[r] = 0.f; }
#pragma unroll
            for (int d0 = 0; d0 < 4; ++d0) {
                const bf16x8 a0 = *(const LAS bf16x8*)(Kb + d0 * 2048), a1 = *(const LAS bf16x8*)(Kb + d0 * 2048 + 512);
                p0 = __builtin_amdgcn_mfma_f32_32x32x16_bf16(a0, qr[d0], p0, 0, 0, 0);
                p1 = __builtin_amdgcn_mfma_f32_32x32x16_bf16(a1, qr[d0], p1, 0, 0, 0);
            }
            const float sb = (float)(64 * j + 4 * hi - tq);
            float mx = -INFINITY;
#pragma unroll
            for (int r = 0; r < 16; ++r) { const float c = (float)((r & 3) + 8 * (r >> 2));
                p0[r] = __builtin_fmaf(-sig, __builtin_fabsf(sb + c), p0[r]); p1[r] = __builtin_fmaf(-sig, __builtin_fabsf(sb + c + 32.0f), p1[r]);
                mx = fmaxf(mx, fmaxf(p0[r], p1[r])); }
            mx = fmaxf(mx, __shfl_xor(mx, 32));
            const float mn = fmaxf(m, mx), alpha = __builtin_amdgcn_exp2f(m - mn);
            float ps = 0.f;
#pragma unroll
            for (int r = 0; r < 16; ++r) { p0[r] = __builtin_amdgcn_exp2f(p0[r] - mn); p1[r] = __builtin_amdgcn_exp2f(p1[r] - mn); ps += p0[r] + p1[r]; }
            l = l * alpha + ps; m = mn;
#pragma unroll
            for (int i = 0; i < 4; ++i)
#pragma unroll
                for (int r = 0; r < 16; ++r) o[i][r] *= alpha;
            u32x4 pw[4];
#pragma unroll
            for (int q = 0; q < 4; ++q) { pw[0][q] = pk2(p0[2 * q], p0[2 * q + 1]); pw[1][q] = pk2(p0[8 + 2 * q], p0[8 + 2 * q + 1]); pw[2][q] = pk2(p1[2 * q], p1[2 * q + 1]); pw[3][q] = pk2(p1[8 + 2 * q], p1[8 + 2 * q + 1]); }
            const LAS unsigned char* Vb = lds + cur * BUF + KBYTES + ((lane >> 4) & 1) * 32 + (lane & 3) * 8 + (4 * hi + ((lane & 15) >> 2)) * 64;
#pragma unroll
            for (int blk = 0; blk < 4; ++blk)
#pragma unroll
                for (int s = 0; s < 4; ++s) {
                    const s16x4 lo = vtr(Vb + blk * 4096 + s * 1024), hh = vtr(Vb + blk * 4096 + s * 1024 + 512);
                    const bf16x8 vf = (bf16x8){lo[0], lo[1], lo[2], lo[3], hh[0], hh[1], hh[2], hh[3]};
                    o[blk] = __builtin_amdgcn_mfma_f32_32x32x16_bf16(vf, __builtin_bit_cast(bf16x8, pw[s]), o[blk], 0, 0, 0);
                }
        }
        if (j > 0) ATT_WRITE((cur ^ 1) * BUF);
        __syncthreads();
        cur ^= 1;
    }
#undef ATT_LOAD
#undef ATT_WRITE
    l += __shfl_xor(l, 32);
    const float inv = 1.0f / l;
    LAS float* X = (LAS float*)(lds + wq * 16384) + lane;
    if (mp == 1) {
#pragma unroll
        for (int i = 0; i < 4; ++i)
#pragma unroll
            for (int r = 0; r < 16; ++r) X[(i * 16 + r) * 64] = o[i][r] * inv;
    }
    __syncthreads();
    if (mp == 0) {
        float ss = 0.f;
#pragma unroll
        for (int i = 0; i < 4; ++i)
#pragma unroll
            for (int r = 0; r < 16; ++r) { const float v = o[i][r] * inv - lam * X[(i * 16 + r) * 64]; o[i][r] = v; ss += v * v; }
        ss += __shfl_xor(ss, 32);
        const float rs = (1.0f / sqrtf(ss * (1.0f / 128.0f) + EPS)) * (1.0f - LAMBDA_INIT);
        bf16* dst = a.A2 + (rowbase + tq) * DM + 512 + h * 128; const bf16* za = a.ACT + (rowbase + tq) * PITCH + C_ZA + h * 128;
#pragma unroll
        for (int i = 0; i < 4; ++i)
#pragma unroll
            for (int g4 = 0; g4 < 4; ++g4) {
                const int dv0 = 32 * i + 8 * g4 + 4 * hi;
                const f32x4 gv = *(const f32x4*)(a.subg + dv0); const u32x2 z = *(const u32x2*)(za + dv0);
                u32x2 ow;
                ow.x = pk2(o[i][4 * g4 + 0] * rs * gv[0] * bf_lo(z.x), o[i][4 * g4 + 1] * rs * gv[1] * bf_hi(z.x));
                ow.y = pk2(o[i][4 * g4 + 2] * rs * gv[2] * bf_lo(z.y), o[i][4 * g4 + 3] * rs * gv[3] * bf_hi(z.y));
                *(u32x2*)(dst + dv0) = ow;
            }
    }
    __syncthreads();
}
__device__ __forceinline__ void phase(const AttArgs& a, LAS unsigned char* lds, int G) {
    const float lam = a.lam[0];
    const int bx = blockIdx.x, vcu = (G % 8 == 0) ? (bx % 8) * (G / 8) + bx / 8 : bx;
    for (int idx = vcu; idx < 1024; idx += G) {
        const int bh = (idx & 255) >> 3, s = idx & 7, k = idx >> 8;
        const int qb = (k == 0) ? s : (k == 1) ? 15 - s : (k == 2) ? 16 + s : 31 - s;
        unit(a, bh >> 2, bh & 3, qb, lam, lds);
    }
}
}

__device__ __forceinline__ void final_phase(const float* x, const float* g_post, const float* sumsq, float* out, int wave, int lane, int G) {
    const int gw = blockIdx.x * 8 + wave, NGW = G * 8;
    f32x4 gp[4];
#pragma unroll
    for (int j = 0; j < 4; ++j) gp[j] = ((const f32x4*)g_post)[lane + 64 * j];
    for (int m = gw; m < TOK; m += NGW) {
        const float rstd = 1.0f / sqrtf(sumsq[m] * (1.0f / DM) + EPS);
        const f32x4* xr = (const f32x4*)(x + (size_t)m * DM) + lane; f32x4* orow = (f32x4*)(out + (size_t)m * DM) + lane;
#pragma unroll
        for (int j = 0; j < 4; ++j) { const f32x4 xv = xr[64 * j], ov = orow[64 * j]; orow[64 * j] = xv + ov * rstd * gp[j]; }
    }
}

#ifndef MK_N_LAUNCHES
#define MK_N_LAUNCHES 1
#endif
struct Args { const float* in[16]; float* out; unsigned char* ws; int ph_lo, ph_hi; };
__global__ void __launch_bounds__(512, 2) fwd_kernel(Args args) {
    extern __shared__ __attribute__((aligned(16))) unsigned char lds_raw[];
    LAS unsigned char* lds = (LAS unsigned char*)lds_raw;
    const int tid = threadIdx.x, lane = tid & 63, wave = __builtin_amdgcn_readfirstlane(tid >> 6), G = gridDim.x;
    unsigned char* ws = args.ws;
    bf16* WIN = (bf16*)(ws + WS_WIN); bf16* WBR = (bf16*)(ws + WS_WBR); bf16* WO = (bf16*)(ws + WS_WO);
    bf16* XN = (bf16*)(ws + WS_XN); bf16* MIX = XN; bf16* ACT = (bf16*)(ws + WS_ACT); bf16* A2 = (bf16*)(ws + WS_A2);
    float* LAM = (float*)(ws + WS_CTL); float* SUMSQ = (float*)(ws + WS_SUMSQ);
    const int lo = args.ph_lo, hi = args.ph_hi;
#define IN(k) (lo <= (k) && (k) < hi)
#define SEAM(k) do { if (IN(k) && IN((k) + 1)) { cg::this_grid().sync(); } } while (0)
    if (IN(0)) {
        P0Args a{args.in[0], args.in[1], args.in[6], args.in[12], args.in[13], args.in[14], args.in[7], args.in[8], args.in[9], args.in[10], WIN, WBR, WO, XN, LAM};
        p0_prologue(a, lds, wave, lane, G);
    }
    SEAM(0);
    if (IN(1)) {
        pg8::Gemm g{XN, WIN, TOK, DIN, DM}; pg8::StaticOrder S; S.init(TOK, DIN, G, (int)blockIdx.x);
        pg8::EpiIn E{ACT};
        pg8::gemm_phase<pg8::EpiIn, pg8::StaticOrder, true, true>(lds, g, S, E);
    }
    SEAM(1);
    if (IN(2)) {
        ConvArgs c{ACT, A2, args.in[2], args.in[3], args.in[4], args.in[5]};
        conv_phase(c, lds, wave, lane, G);
        AttArgs a{ACT, A2, args.in[11], LAM};
        att::phase(a, lds, G);
    }
    SEAM(2);
    if (IN(3)) {
        pg8::Gemm g{A2, WBR, TOK, DM, DM}; pg8::StaticOrder S; S.init(TOK, DM, G, (int)blockIdx.x);
        pg8::EpiMix E{ACT, MIX};
        pg8::gemm_phase<pg8::EpiMix, pg8::StaticOrder, true, true, 8>(lds, g, S, E);
    }
    SEAM(3);
    if (IN(4)) {
        pg8::Gemm g{MIX, WO, TOK, DM, DM}; pg8::StaticOrder S; S.init(TOK, DM, G, (int)blockIdx.x);
        pg8::EpiOut E{args.out, SUMSQ};
        pg8::gemm_phase<pg8::EpiOut, pg8::StaticOrder, true, true>(lds, g, S, E);
    }
    SEAM(4);
    if (IN(5)) final_phase(args.in[0], args.in[15], SUMSQ, args.out, wave, lane, G);
#undef IN
#undef SEAM
}

extern "C" void kernel_launch(void* const* d_in, const int* in_sizes, int n_in, void* d_out, int out_size, void* d_ws, size_t ws_size, hipStream_t stream) {
    static int grid = 0;
    if (grid == 0) {
        if (n_in != 16 || in_sizes[0] != TOK * DM || out_size != TOK * DM || ws_size < WS_END) { fprintf(stderr, "kernel_launch: unexpected shapes (n_in %d, in0 %d, out %d, ws %zu)\n", n_in, n_in > 0 ? in_sizes[0] : -1, out_size, ws_size); grid = -1; return; }
        int dev = 0, cus = 0, per_cu = 0;
        if (hipGetDevice(&dev) != hipSuccess || hipDeviceGetAttribute(&cus, hipDeviceAttributeMultiprocessorCount, dev) != hipSuccess) { grid = -1; return; }
        if (hipFuncSetAttribute((const void*)fwd_kernel, hipFuncAttributeMaxDynamicSharedMemorySize, LDS_BYTES) != hipSuccess) { fprintf(stderr, "kernel_launch: hipFuncSetAttribute failed\n"); grid = -1; return; }
        if (hipOccupancyMaxActiveBlocksPerMultiprocessor(&per_cu, (const void*)fwd_kernel, 512, LDS_BYTES) != hipSuccess || per_cu < 1) { fprintf(stderr, "kernel_launch: occupancy query failed (%d)\n", per_cu); per_cu = 1; }
        (void)hipGetLastError();
        grid = cus;
    }
    if (grid < 0) return;
    (void)hipMemsetAsync((char*)d_ws + WS_CTL, 0, CTL_ZERO_BYTES, stream);
    Args a{};
    for (int i = 0; i < 16; ++i) a.in[i] = (const float*)d_in[i];
    a.out = (float*)d_out; a.ws = (unsigned char*)d_ws;
#if MK_N_LAUNCHES == 1
    a.ph_lo = 0; a.ph_hi = 6;
    void* kargs[] = {&a};
    hipError_t e = hipLaunchCooperativeKernel((const void*)fwd_kernel, dim3(grid), dim3(512), kargs, LDS_BYTES, stream);
    if (e != hipSuccess) fprintf(stderr, "kernel_launch: cooperative launch failed: %s (grid %d)\n", hipGetErrorString(e), grid);
#else
    for (int p = 0; p < 6; ++p) {
        a.ph_lo = p; a.ph_hi = p + 1;
        hipLaunchKernelGGL(fwd_kernel, dim3(grid), dim3(512), LDS_BYTES, stream, a);
    }
#endif
}
```

```cpp
#include <hip/hip_runtime.h>
#include <hip/hip_cooperative_groups.h>
#include <cstdio>
#include <cstdint>
namespace cg = cooperative_groups;

namespace pg8 {
#define PG8_LAS __attribute__((address_space(3)))
typedef unsigned short bf16_t;
typedef short bf16x8 __attribute__((ext_vector_type(8)));
typedef float f32x4 __attribute__((ext_vector_type(4)));
typedef unsigned u32x4 __attribute__((ext_vector_type(4)));
constexpr int BM = 256, BK = 64, HALF = 128, HTB = HALF * BK * 2  , STAGE_BYTES = 8 * HTB, NXCD = 8, WGM = 8;

__host__ __device__ __forceinline__ int lds_byte(int r, int c) { const int st = (r >> 4) * 2 + (c >> 5), rr = r & 15, cc = c & 31, ob = rr * 64 + cc * 2; return st * 1024 + (ob ^ (((ob >> 9) & 1) << 5)); }
__host__ __device__ __forceinline__ void stage_rc(int b, int& R, int& C) { const int st = b / 1024, sb = b % 1024, swz = sb ^ (((sb >> 9) & 1) << 5); R = (st >> 1) * 16 + swz / 64; C = (st & 1) * 32 + (swz % 64) / 2; }
__host__ __device__ __forceinline__ int perm32(int rho) { const int n = rho >> 4, i = rho & 15; return 8 * (i >> 2) + 4 * n + (i & 3); }

struct Unit { int pm, pn; };
struct Gemm { const bf16_t* A; const bf16_t* Bt; int M, N, K; };

struct StaticOrder {
    int nM, nN, nwg, G, c;
    __host__ __device__ void init(int M, int N, int G_, int c_) { nM = M / BM; nN = N / BM; nwg = nM * nN; G = G_; c = c_; }
    __host__ __device__ bool next(int i, Unit& u) const {
        const long L = (long)i * G + c; if (L >= nwg) return false;
        int wgid = (int)L; { const int q = nwg / NXCD, r = nwg % NXCD, xcd = wgid % NXCD, off = wgid / NXCD; wgid = (xcd < r ? xcd * (q + 1) : r * (q + 1) + (xcd - r) * q) + off; }
        const int nig = WGM * nN, gid = wgid / nig, fm = gid * WGM, gsz = (nM - fm) < WGM ? (nM - fm) : WGM;
        u.pm = fm + ((wgid % nig) % gsz); u.pn = (wgid % nig) / gsz; return true;
    }
    __device__ __forceinline__ void a_ready(const Unit&) const {}
    __device__ __forceinline__ void done(const Unit&) const {}
};


__device__ __forceinline__ unsigned cvt_pk_bf16(float lo, float hi) { unsigned r; asm volatile("v_cvt_pk_bf16_f32 %0, %1, %2" : "=v"(r) : "v"(lo), "v"(hi)); return r; }
__device__ __forceinline__ float fsigmoid(float x) { return __builtin_amdgcn_rcpf(1.0f + __builtin_amdgcn_exp2f(-1.4426950408889634f * x)); }
__device__ __forceinline__ float bf_lo(unsigned w) { return __builtin_bit_cast(float, w << 16); }
__device__ __forceinline__ float bf_hi(unsigned w) { return __builtin_bit_cast(float, w & 0xffff0000u); }
constexpr int ACT_PITCH = 5120;
constexpr float QSCALE = 0.125f * 1.4426950408889634f;

struct EpiIn {
    static constexpr bool PERM = true, AFTER_DRAIN = false;
    bf16_t* ACT;
    __device__ __forceinline__ void operator()(const f32x4 (&acc)[2][2][4][2], const Unit& u, int wr, int wc, int fr, int fq) const {
        const int row0 = u.pm * BM + wr * 64 + fr; const int pn = u.pn;
        if (pn < 4) {
            const int col = pn * 128 + wc * 32 + 8 * fq;
#pragma unroll
            for (int ai = 0; ai < 2; ++ai)
#pragma unroll
                for (int m = 0; m < 4; ++m) {
                    bf16_t* p = ACT + (size_t)(row0 + ai * HALF + m * 16) * ACT_PITCH + col;
                    const f32x4 a0 = acc[ai][0][m][0], a1 = acc[ai][0][m][1], b0 = acc[ai][1][m][0], b1 = acc[ai][1][m][1];
                    u32x4 w;
                    w.x = cvt_pk_bf16(a0[0] * fsigmoid(b0[0]), a0[1] * fsigmoid(b0[1])); w.y = cvt_pk_bf16(a0[2] * fsigmoid(b0[2]), a0[3] * fsigmoid(b0[3]));
                    w.z = cvt_pk_bf16(a1[0] * fsigmoid(b1[0]), a1[1] * fsigmoid(b1[1])); w.w = cvt_pk_bf16(a1[2] * fsigmoid(b1[2]), a1[3] * fsigmoid(b1[3]));
                    *(u32x4*)p = w;
                }
        } else {
            const int act = (pn < 6) ? 1 : (pn < 8) ? 3 : (pn < 12) ? 0 : (pn < 14) ? 1 : 2;
            const int col = pn * 256 - 512 + wc * 32 + 8 * fq;
#pragma unroll
            for (int ai = 0; ai < 2; ++ai)
#pragma unroll
                for (int m = 0; m < 4; ++m) {
                    bf16_t* p = ACT + (size_t)(row0 + ai * HALF + m * 16) * ACT_PITCH + col;
#pragma unroll
                    for (int bj = 0; bj < 2; ++bj) {
                        f32x4 v0 = acc[ai][bj][m][0], v1 = acc[ai][bj][m][1];
                        if (act == 1) {
#pragma unroll
                            for (int j = 0; j < 4; ++j) { v0[j] = v0[j] * fsigmoid(v0[j]); v1[j] = v1[j] * fsigmoid(v1[j]); }
                        } else if (act == 2) {
#pragma unroll
                            for (int j = 0; j < 4; ++j) { v0[j] = fsigmoid(v0[j]); v1[j] = fsigmoid(v1[j]); }
                        } else if (act == 3) { v0 = v0 * QSCALE; v1 = v1 * QSCALE; }
                        u32x4 w; w.x = cvt_pk_bf16(v0[0], v0[1]); w.y = cvt_pk_bf16(v0[2], v0[3]); w.z = cvt_pk_bf16(v1[0], v1[1]); w.w = cvt_pk_bf16(v1[2], v1[3]);
                        *(u32x4*)(p + bj * HALF) = w;
                    }
                }
        }
    }
};

struct EpiMix {
    static constexpr bool PERM = true, AFTER_DRAIN = false;
    const bf16_t* ACT; bf16_t* MIX;
    __device__ __forceinline__ void mid(f32x4 (&acc)[2][2][4][2], const Unit& u, int wr, int wc, int fr, int fq) const {
        int row0 = u.pm * BM + wr * 64 + fr, col = u.pn * BM + wc * 32 + 8 * fq;
        asm volatile("" : "+v"(row0), "+v"(col));
#pragma unroll
        for (int ai = 0; ai < 2; ++ai)
#pragma unroll
            for (int m = 0; m < 4; ++m) {
                const bf16_t* g = ACT + (size_t)(row0 + ai * HALF + m * 16) * ACT_PITCH + 3072 + col;
#pragma unroll
                for (int bj = 0; bj < 2; ++bj) {
                    const u32x4 g0 = *(const u32x4*)(g + bj * HALF), g1 = *(const u32x4*)(g + 1024 + bj * HALF);
                    f32x4 r0, r1;
                    r0[0] = bf_lo(g0.x) * __builtin_amdgcn_rcpf(fmaxf(bf_lo(g1.x), 1e-20f)); r0[1] = bf_hi(g0.x) * __builtin_amdgcn_rcpf(fmaxf(bf_hi(g1.x), 1e-20f));
                    r0[2] = bf_lo(g0.y) * __builtin_amdgcn_rcpf(fmaxf(bf_lo(g1.y), 1e-20f)); r0[3] = bf_hi(g0.y) * __builtin_amdgcn_rcpf(fmaxf(bf_hi(g1.y), 1e-20f));
                    r1[0] = bf_lo(g0.z) * __builtin_amdgcn_rcpf(fmaxf(bf_lo(g1.z), 1e-20f)); r1[1] = bf_hi(g0.z) * __builtin_amdgcn_rcpf(fmaxf(bf_hi(g1.z), 1e-20f));
                    r1[2] = bf_lo(g0.w) * __builtin_amdgcn_rcpf(fmaxf(bf_lo(g1.w), 1e-20f)); r1[3] = bf_hi(g0.w) * __builtin_amdgcn_rcpf(fmaxf(bf_hi(g1.w), 1e-20f));
                    acc[ai][bj][m][0] = acc[ai][bj][m][0] * r0; acc[ai][bj][m][1] = acc[ai][bj][m][1] * r1;
                }
                asm volatile("" ::: "memory");
            }
    }
    __device__ __forceinline__ void operator()(const f32x4 (&acc)[2][2][4][2], const Unit& u, int wr, int wc, int fr, int fq) const {
        const int row0 = u.pm * BM + wr * 64 + fr, col = u.pn * BM + wc * 32 + 8 * fq;
#pragma unroll
        for (int ai = 0; ai < 2; ++ai)
#pragma unroll
            for (int m = 0; m < 4; ++m) {
                const size_t r = (size_t)(row0 + ai * HALF + m * 16);
                const bf16_t* g = ACT + r * ACT_PITCH + 4096 + col; bf16_t* p = MIX + r * 1024 + col;
#pragma unroll
                for (int bj = 0; bj < 2; ++bj) {
                    const u32x4 g1 = *(const u32x4*)(g + bj * HALF);
                    const f32x4 v0 = acc[ai][bj][m][0], v1 = acc[ai][bj][m][1];
                    u32x4 w;
                    w.x = cvt_pk_bf16(v0[0] * fmaxf(bf_lo(g1.x), 1e-20f), v0[1] * fmaxf(bf_hi(g1.x), 1e-20f)); w.y = cvt_pk_bf16(v0[2] * fmaxf(bf_lo(g1.y), 1e-20f), v0[3] * fmaxf(bf_hi(g1.y), 1e-20f));
                    w.z = cvt_pk_bf16(v1[0] * fmaxf(bf_lo(g1.z), 1e-20f), v1[1] * fmaxf(bf_hi(g1.z), 1e-20f)); w.w = cvt_pk_bf16(v1[2] * fmaxf(bf_lo(g1.w), 1e-20f), v1[3] * fmaxf(bf_hi(g1.w), 1e-20f));
                    *(u32x4*)(p + bj * HALF) = w;
                }
                asm volatile("" ::: "memory");
            }
    }
};

struct EpiOut {
    static constexpr bool PERM = false, AFTER_DRAIN = false;
    float* OUT; float* SUMSQ; float sscale;
    __device__ __forceinline__ void operator()(const f32x4 (&acc)[2][2][4][2], const Unit& u, int wr, int wc, int fr, int fq) const {
        const int row0 = u.pm * BM + wr * 64 + fr, col0 = u.pn * BM + wc * 32 + 4 * fq;
#pragma unroll
        for (int ai = 0; ai < 2; ++ai)
#pragma unroll
            for (int m = 0; m < 4; ++m) {
                const int row = row0 + ai * HALF + m * 16; float* rowp = OUT + (size_t)row * 1024 + col0; float s = 0.f;
#pragma unroll
                for (int bj = 0; bj < 2; ++bj)
#pragma unroll
                    for (int n = 0; n < 2; ++n) { const f32x4 v = acc[ai][bj][m][n]; *(f32x4*)(rowp + bj * HALF + n * 16) = v; s += (v[0] * v[0] + v[1] * v[1]) + (v[2] * v[2] + v[3] * v[3]); }
                s += __shfl_xor(s, 16); s += __shfl_xor(s, 32);
                if (fq == 0) atomicAdd(SUMSQ + row, s * sscale);
            }
    }
};

template <class Epi, class Sched, bool ALIGN_EPI = false, bool SP2 = false, int MIDK = 0>
__device__ __forceinline__ void gemm_phase(PG8_LAS unsigned char* lds, const Gemm g, const Sched& S, const Epi& E) {
    const int tid = threadIdx.x, wid = __builtin_amdgcn_readfirstlane(tid >> 6), lane = tid & 63, wr = wid >> 2, wc = wid & 3, fr = lane & 15, fq = lane >> 4;
    const int K = g.K, nt = K / BK;
    unsigned voffA[2], voffB[2];
#pragma unroll
    for (int i = 0; i < 2; ++i) { int R, C; stage_rc(tid * 16 + i * 8192, R, C); const int Rb = Epi::PERM ? ((R & ~31) + perm32(R & 31)) : R;
        voffA[i] = (unsigned)(R * K + C) * 2u; voffB[i] = (unsigned)(Rb * K + C) * 2u; }
    const size_t kstep = (size_t)(BK * 2);
    const size_t hstep = (size_t)HALF * K * 2;
    const size_t tstep = 2 * hstep;
    const unsigned ldsw = (unsigned)wid * 1024u;
    const int aoff = lds_byte(wr * 64 + fr, fq * 8), boff = lds_byte(wc * 32 + fr, fq * 8);
#define PG8_SA(b, h) (((b) * 2 + (h)) * HTB)
#define PG8_SB(b, h) ((4 + (b) * 2 + (h)) * HTB)
#define PG8_STAGE(bufoff, gbase, voff) do { _Pragma("unroll") for (int _i = 0; _i < 2; ++_i) \
        __builtin_amdgcn_global_load_lds((const unsigned*)((const char*)(gbase) + (voff)[_i]), (PG8_LAS unsigned*)(lds + (bufoff) + ldsw + _i * 8192), 16, 0, 0); } while (0)
#define PG8_LDA(dst, b, h) do { _Pragma("unroll") for (int m = 0; m < 4; ++m) _Pragma("unroll") for (int k = 0; k < 2; ++k) dst[m][k] = *(const PG8_LAS bf16x8*)(lds + PG8_SA(b, h) + aoff + m * 2048 + k * 1024); } while (0)
#define PG8_LDB(dst, b, h) do { _Pragma("unroll") for (int n = 0; n < 2; ++n) _Pragma("unroll") for (int k = 0; k < 2; ++k) dst[n][k] = *(const PG8_LAS bf16x8*)(lds + PG8_SB(b, h) + boff + n * 2048 + k * 1024); } while (0)
#define PG8_MMA(ai, bj, At, Bt) do { __builtin_amdgcn_s_setprio(1); _Pragma("unroll") for (int m = 0; m < 4; ++m) _Pragma("unroll") for (int n = 0; n < 2; ++n) _Pragma("unroll") for (int k = 0; k < 2; ++k) \
        acc[ai][bj][m][n] = __builtin_amdgcn_mfma_f32_16x16x32_bf16(Bt[n][k], At[m][k], acc[ai][bj][m][n], 0, 0, 0); __builtin_amdgcn_s_setprio(0); } while (0)
#define PG8_WAIT_V(n) asm volatile("s_waitcnt vmcnt(" #n ")" ::: "memory")
#define PG8_WAIT_L(n) asm volatile("s_waitcnt lgkmcnt(" #n ")" ::: "memory")
#define PG8_BAR __builtin_amdgcn_s_barrier()
#define PG8_SCHED __builtin_amdgcn_sched_barrier(0)
    Unit cur, nxt; int ui = 0;
    if (!S.next(0, cur)) return;
    f32x4 acc[2][2][4][2];
#pragma unroll
    for (int a = 0; a < 2; ++a)
#pragma unroll
        for (int b = 0; b < 2; ++b)
#pragma unroll
            for (int m = 0; m < 4; ++m)
#pragma unroll
                for (int n = 0; n < 2; ++n) acc[a][b][m][n] = (f32x4){0.f, 0.f, 0.f, 0.f};
    bf16x8 At[4][2], B0[2][2], B1[2][2];
    const char* cA = (const char*)g.A + (size_t)cur.pm * tstep; const char* cB = (const char*)g.Bt + (size_t)cur.pn * tstep;
    S.a_ready(cur);
    if constexpr (SP2) {
        PG8_STAGE(PG8_SB(0, 0), cB, voffB); PG8_STAGE(PG8_SB(0, 1), cB + hstep, voffB); PG8_STAGE(PG8_SA(0, 0), cA, voffA); PG8_STAGE(PG8_SA(0, 1), cA + hstep, voffA);
        if (wr == 1) PG8_BAR;
        PG8_WAIT_V(2); PG8_BAR;
        PG8_STAGE(PG8_SB(1, 0), cB + kstep, voffB); PG8_STAGE(PG8_SA(1, 0), cA + kstep, voffA); PG8_STAGE(PG8_SB(1, 1), cB + hstep + kstep, voffB);
        PG8_WAIT_V(6); PG8_BAR;
    } else {
        PG8_STAGE(PG8_SB(0, 0), cB, voffB); PG8_STAGE(PG8_SA(0, 0), cA, voffA); PG8_STAGE(PG8_SB(0, 1), cB + hstep, voffB); PG8_STAGE(PG8_SA(0, 1), cA + hstep, voffA);
        if (wr == 1) PG8_BAR;
        PG8_WAIT_V(4); PG8_BAR;
        PG8_STAGE(PG8_SB(1, 0), cB + kstep, voffB); PG8_STAGE(PG8_SA(1, 0), cA + kstep, voffA); PG8_STAGE(PG8_SB(1, 1), cB + hstep + kstep, voffB);
        PG8_WAIT_V(6); PG8_BAR;
    }
    for (;;) {
        const bool has_next = S.next(ui + 1, nxt);
        const char* nA = has_next ? (const char*)g.A + (size_t)nxt.pm * tstep : cA; const char* nB = has_next ? (const char*)g.Bt + (size_t)nxt.pn * tstep : cB;
        for (int t = 0; t < nt; t += 2) {
            if constexpr (MIDK > 0) { if (t == MIDK) E.mid(acc, cur, wr, wc, fr, fq); }
            const bool last = (t == nt - 2);
            const char* a1 = cA + (size_t)(t + 1) * kstep;
            const char* a2 = last ? nA : cA + (size_t)(t + 2) * kstep; const char* b2 = last ? nB : cB + (size_t)(t + 2) * kstep;
            const char* a3 = a2 + kstep; const char* b3 = b2 + kstep;
            if (last && has_next) S.a_ready(nxt);
            if constexpr (SP2) {
            PG8_LDB(B0, 0, 0); PG8_LDB(B1, 0, 1); PG8_SCHED; PG8_LDA(At, 0, 0); PG8_STAGE(PG8_SA(1, 1), a1 + hstep, voffA);
            PG8_WAIT_V(8); PG8_WAIT_L(0); PG8_BAR; PG8_MMA(0, 0, At, B0); PG8_MMA(0, 1, At, B1); PG8_BAR; PG8_SCHED;
            PG8_LDA(At, 0, 1); PG8_STAGE(PG8_SB(0, 0), b2, voffB); PG8_STAGE(PG8_SB(0, 1), b2 + hstep, voffB); PG8_STAGE(PG8_SA(0, 0), a2, voffA);
            PG8_WAIT_V(8); PG8_WAIT_L(0); PG8_BAR; PG8_MMA(1, 0, At, B0); PG8_MMA(1, 1, At, B1); PG8_BAR; PG8_SCHED;
            PG8_LDB(B0, 1, 0); PG8_LDB(B1, 1, 1); PG8_SCHED; PG8_LDA(At, 1, 0); PG8_STAGE(PG8_SA(0, 1), a2 + hstep, voffA);
            PG8_WAIT_V(8); PG8_WAIT_L(0); PG8_BAR; PG8_MMA(0, 0, At, B0); PG8_MMA(0, 1, At, B1); PG8_BAR; PG8_SCHED;
            PG8_LDA(At, 1, 1); PG8_STAGE(PG8_SB(1, 0), b3, voffB); PG8_STAGE(PG8_SB(1, 1), b3 + hstep, voffB); PG8_STAGE(PG8_SA(1, 0), a3, voffA);
            PG8_WAIT_V(8); PG8_WAIT_L(0); PG8_BAR; PG8_MMA(1, 0, At, B0); PG8_MMA(1, 1, At, B1); PG8_BAR; PG8_SCHED;
            } else {
            PG8_LDB(B0, 0, 0); PG8_SCHED; PG8_LDA(At, 0, 0); PG8_STAGE(PG8_SA(1, 1), a1 + hstep, voffA);
            PG8_WAIT_L(8); PG8_BAR; PG8_WAIT_L(0); PG8_MMA(0, 0, At, B0); PG8_BAR; PG8_SCHED;
            PG8_LDB(B1, 0, 1); PG8_STAGE(PG8_SB(0, 0), b2, voffB);
            PG8_BAR; PG8_WAIT_L(0); PG8_MMA(0, 1, At, B1); PG8_BAR;
            PG8_LDA(At, 0, 1); PG8_STAGE(PG8_SA(0, 0), a2, voffA);
            PG8_BAR; PG8_WAIT_L(0); PG8_MMA(1, 0, At, B0); PG8_BAR; PG8_SCHED;
            PG8_STAGE(PG8_SB(0, 1), b2 + hstep, voffB);
            PG8_WAIT_V(6); PG8_BAR; PG8_MMA(1, 1, At, B1); PG8_BAR;
            PG8_LDB(B0, 1, 0); PG8_SCHED; PG8_LDA(At, 1, 0); PG8_STAGE(PG8_SA(0, 1), a2 + hstep, voffA);
            PG8_WAIT_L(8); PG8_BAR; PG8_WAIT_L(0); PG8_MMA(0, 0, At, B0); PG8_BAR; PG8_SCHED;
            PG8_LDB(B1, 1, 1); PG8_STAGE(PG8_SB(1, 0), b3, voffB);
            PG8_BAR; PG8_WAIT_L(0); PG8_MMA(0, 1, At, B1); PG8_BAR;
            PG8_LDA(At, 1, 1); PG8_STAGE(PG8_SA(1, 0), a3, voffA);
            PG8_BAR; PG8_WAIT_L(0); PG8_MMA(1, 0, At, B0); PG8_BAR; PG8_SCHED;
            PG8_STAGE(PG8_SB(1, 1), b3 + hstep, voffB);
            PG8_WAIT_V(6); PG8_BAR; PG8_MMA(1, 1, At, B1); PG8_BAR;
            }
        }
        if constexpr (ALIGN_EPI) { if (wr == 0) PG8_BAR; }
        if constexpr (!Epi::AFTER_DRAIN) { E(acc, cur, wr, wc, fr, fq); S.done(cur); }
        if (!has_next) break;
#pragma unroll
        for (int a = 0; a < 2; ++a)
#pragma unroll
            for (int b = 0; b < 2; ++b)
#pragma unroll
                for (int m = 0; m < 4; ++m)
#pragma unroll
                    for (int n = 0; n < 2; ++n) acc[a][b][m][n] = (f32x4){0.f, 0.f, 0.f, 0.f};
        cur = nxt; cA = nA; cB = nB; ++ui;
        if constexpr (ALIGN_EPI) { if (wr == 1) PG8_BAR; }
    }
    PG8_WAIT_V(0);
    if constexpr (!ALIGN_EPI) { if (wr == 0) PG8_BAR; }
    PG8_BAR;
    if constexpr (Epi::AFTER_DRAIN) { E.fused(acc, cur, wr, wc, fr, fq, lds, wid, lane); S.done(cur); }
#undef PG8_SA
#undef PG8_SB
#undef PG8_STAGE
#undef PG8_LDA
#undef PG8_LDB
#undef PG8_MMA
#undef PG8_WAIT_V
#undef PG8_WAIT_L
#undef PG8_BAR
#undef PG8_SCHED
}
}

#define LAS __attribute__((address_space(3)))
typedef unsigned short bf16;
typedef short bf16x8 __attribute__((ext_vector_type(8)));
typedef short s16x4 __attribute__((ext_vector_type(4)));
typedef float f32x4 __attribute__((ext_vector_type(4)));
typedef float f32x16 __attribute__((ext_vector_type(16)));
typedef unsigned u32x4 __attribute__((ext_vector_type(4)));
typedef unsigned u32x2 __attribute__((ext_vector_type(2)));

constexpr int NB = 8, SEQ = 4096, DM = 1024, TOK = NB * SEQ;
constexpr int DCONV = 512, CW = 31, NH = 4, DIN = 5632, PITCH = pg8::ACT_PITCH;
constexpr int C_HG = 0, C_ZC = 512, C_Q = 1024, C_K = 1536, C_V = 2048, C_ZA = 2560, C_G0 = 3072, C_G1 = 4096;
constexpr float EPS = 1e-6f, LAMBDA_INIT = 0.2f, LOG2E = 1.4426950408889634f;
constexpr size_t MiB = 1u << 20;
constexpr size_t WS_CTL = 0, CTL_ZERO_BYTES = 1 * MiB;
constexpr size_t WS_BAR = 64 * 1024;
constexpr size_t WS_SUMSQ = 256 * 1024;
constexpr size_t WS_WIN = 2 * MiB;
constexpr size_t WS_WBR = 14 * MiB;
constexpr size_t WS_WO = 16 * MiB;
constexpr size_t WS_XN = 32 * MiB;
constexpr size_t WS_ACT = 96 * MiB;
constexpr size_t WS_A2 = 416 * MiB;
constexpr size_t WS_END = 480 * MiB;
constexpr int LDS_BYTES = 131072 + 1024;

__device__ __forceinline__ float wave_sum(float v) {
#pragma unroll
    for (int o = 1; o < 64; o <<= 1) v += __shfl_xor(v, o);
    return v;
}
__device__ __forceinline__ unsigned pk2(float lo, float hi) { return pg8::cvt_pk_bf16(lo, hi); }
using pg8::bf_lo; using pg8::bf_hi; using pg8::fsigmoid;

__device__ __forceinline__ void p0_transpose_item(const float* W, int N, int k0, int n0, bf16* WT, int drow0, int ldk, int koff, const float* kscale, LAS float* scr, int lane) {
#pragma unroll 8
    for (int i = 0; i < 32; ++i) { const int kk = 2 * i + (lane >> 5); float v = W[(size_t)(k0 + kk) * N + n0 + (lane & 31)]; if (kscale) v *= kscale[k0 + kk]; scr[kk * 33 + (lane & 31)] = v; }
    asm volatile("s_waitcnt lgkmcnt(0)" ::: "memory");
    const int c = lane & 7;
#pragma unroll
    for (int j = 0; j < 4; ++j) { const int n = (lane >> 3) + 8 * j; const LAS float* s = scr + (8 * c) * 33 + n;
        u32x4 o; o.x = pk2(s[0 * 33], s[1 * 33]); o.y = pk2(s[2 * 33], s[3 * 33]); o.z = pk2(s[4 * 33], s[5 * 33]); o.w = pk2(s[6 * 33], s[7 * 33]);
        *(u32x4*)(WT + (size_t)(drow0 + n) * ldk + koff + k0 + 8 * c) = o; }
    asm volatile("s_waitcnt lgkmcnt(0)" ::: "memory");
}
struct P0Args { const float *x, *w_in, *w_cp, *w_ap, *w_out, *g_pre, *lq1, *lk1, *lq2, *lk2; bf16 *WIN, *WBR, *WO, *XN; float* lam; };
__device__ __forceinline__ void p0_prologue(const P0Args& a, LAS unsigned char* lds, int wave, int lane, int G) {
    LAS float* scr = (LAS float*)(lds + wave * 16384);
    const int gw = blockIdx.x * 8 + wave, NGW = G * 8;
    constexpr int I_IN = (DM / 64) * (DIN / 32), I_CP = (DCONV / 64) * (DM / 32), I_AP = I_CP, I_O = (DM / 64) * (DM / 32);
    constexpr int NITEMS = I_IN + I_CP + I_AP + I_O;
    for (int it = gw; it < NITEMS; it += NGW) {
        int r = it;
        if (r < I_IN) { const int nblk = DIN / 32, kb = r / nblk, nb = r % nblk, n0 = 32 * nb;
            int d0 = n0; if (n0 < 1024) { const int bjj = n0 >> 9, ch = n0 & 511; d0 = 256 * (ch >> 7) + 128 * bjj + (ch & 127); }
            p0_transpose_item(a.w_in, DIN, 64 * kb, n0, a.WIN, d0, DM, 0, a.g_pre, scr, lane); continue; }
        r -= I_IN;
        if (r < I_CP) { const int nblk = DM / 32, kb = r / nblk, nb = r % nblk; p0_transpose_item(a.w_cp, DM, 64 * kb, 32 * nb, a.WBR, 32 * nb, DM, 0, nullptr, scr, lane); continue; }
        r -= I_CP;
        if (r < I_AP) { const int nblk = DM / 32, kb = r / nblk, nb = r % nblk; p0_transpose_item(a.w_ap, DM, 64 * kb, 32 * nb, a.WBR, 32 * nb, DM, 512, nullptr, scr, lane); continue; }
        r -= I_AP;
        { const int nblk = DM / 32, kb = r / nblk, nb = r % nblk; p0_transpose_item(a.w_out, DM, 64 * kb, 32 * nb, a.WO, 32 * nb, DM, 0, nullptr, scr, lane); }
    }
    for (int m = gw; m < TOK; m += NGW) {
        const f32x4* xr = (const f32x4*)(a.x + (size_t)m * DM) + lane;
        f32x4 v[4]; float s = 0.f;
#pragma unroll
        for (int j = 0; j < 4; ++j) { v[j] = xr[64 * j]; s += (v[j][0] * v[j][0] + v[j][1] * v[j][1]) + (v[j][2] * v[j][2] + v[j][3] * v[j][3]); }
        const float rstd = 1.0f / sqrtf(wave_sum(s) * (1.0f / DM) + EPS);
        u32x2* o8 = (u32x2*)(a.XN + (size_t)m * DM) + lane;
#pragma unroll
        for (int j = 0; j < 4; ++j) { u32x2 w; w.x = pk2(v[j][0] * rstd, v[j][1] * rstd); w.y = pk2(v[j][2] * rstd, v[j][3] * rstd); o8[64 * j] = w; }
    }
    if (blockIdx.x == 0 && wave == 0) {
        const float s1 = wave_sum(a.lq1[lane] * a.lk1[lane]), s2 = wave_sum(a.lq2[lane] * a.lk2[lane]);
        if (lane == 0) a.lam[0] = expf(s1) - expf(s2) + LAMBDA_INIT;
    }
}

struct ConvArgs { const bf16* ACT; bf16* A2; const float *cw, *cb, *lng, *lnb; };
__device__ __forceinline__ void conv_phase(const ConvArgs& a, LAS unsigned char* lds, int wave, int lane, int G) {
    const int tid = threadIdx.x;
    LAS bf16* IN = (LAS bf16*)lds;
    LAS float* CV = (LAS float*)(lds + 65536);
    float w[CW];
#pragma unroll
    for (int j = 0; j < CW; ++j) w[j] = a.cw[j * DCONV + tid];
    const float cb = a.cb[tid];
    for (int u = blockIdx.x; u < TOK / 32; u += G) {
        const int b = u / (SEQ / 32), t0 = (u % (SEQ / 32)) * 32; const size_t rowbase = (size_t)b * SEQ;
        for (int p = tid; p < 62 * 64; p += 512) { const int row = p >> 6, c = p & 63, tt = t0 - 30 + row;
            u32x4 v = (u32x4){0u, 0u, 0u, 0u};
            if (tt >= 0) v = *(const u32x4*)(a.ACT + (rowbase + tt) * PITCH + C_HG + c * 8);
            *(LAS u32x4*)(IN + row * 512 + c * 8) = v; }
        __syncthreads();
#pragma unroll 1
        for (int g = 0; g < 4; ++g) {
            float xin[38];
#pragma unroll
            for (int i = 0; i < 38; ++i) xin[i] = __builtin_bit_cast(float, (unsigned)IN[(8 * g + i) * 512 + tid] << 16);
#pragma unroll
            for (int tk = 0; tk < 8; ++tk) { float acc = cb;
#pragma unroll
                for (int j = 0; j < CW; ++j) acc = __builtin_fmaf(xin[tk + j], w[j], acc);
                CV[(8 * g + tk) * 512 + tid] = acc; }
        }
        __syncthreads();
#pragma unroll 1
        for (int i = 0; i < 4; ++i) {
            const int tl = wave * 4 + i; const size_t row = rowbase + t0 + tl; const int c0 = lane * 8;
            const f32x4 v0 = *(const LAS f32x4*)(CV + tl * 512 + c0), v1 = *(const LAS f32x4*)(CV + tl * 512 + c0 + 4);
            const float mean = wave_sum((v0[0] + v0[1]) + (v0[2] + v0[3]) + (v1[0] + v1[1]) + (v1[2] + v1[3])) * (1.0f / DCONV);
            const f32x4 d0 = v0 - mean, d1 = v1 - mean;
            const float var = wave_sum((d0[0] * d0[0] + d0[1] * d0[1]) + (d0[2] * d0[2] + d0[3] * d0[3]) + (d1[0] * d1[0] + d1[1] * d1[1]) + (d1[2] * d1[2] + d1[3] * d1[3])) * (1.0f / DCONV);
            const float rstd = 1.0f / sqrtf(var + EPS);
            const f32x4 g0 = *(const f32x4*)(a.lng + c0), g1 = *(const f32x4*)(a.lng + c0 + 4), b0 = *(const f32x4*)(a.lnb + c0), b1 = *(const f32x4*)(a.lnb + c0 + 4);
            const u32x4 z = *(const u32x4*)(a.ACT + row * PITCH + C_ZC + c0);
            f32x4 y0 = d0 * rstd * g0 + b0, y1 = d1 * rstd * g1 + b1;
#pragma unroll
            for (int j = 0; j < 4; ++j) { y0[j] = y0[j] * fsigmoid(y0[j]); y1[j] = y1[j] * fsigmoid(y1[j]); }
            u32x4 o;
            o.x = pk2(y0[0] * bf_lo(z.x), y0[1] * bf_hi(z.x)); o.y = pk2(y0[2] * bf_lo(z.y), y0[3] * bf_hi(z.y));
            o.z = pk2(y1[0] * bf_lo(z.z), y1[1] * bf_hi(z.z)); o.w = pk2(y1[2] * bf_lo(z.w), y1[3] * bf_hi(z.w));
            *(u32x4*)(a.A2 + row * DM + c0) = o;
        }
        __syncthreads();
    }
}

struct AttArgs { const bf16* ACT; bf16* A2; const float* subg; const float* lam; };
namespace att {
constexpr int KBYTES = 16384, BUF = 32768;
constexpr float ATT_THR = 8.0f;
#define MAX3(a, b, c) __builtin_fmaxf(__builtin_fmaxf((a), (b)), (c))
__device__ __forceinline__ int crow(int r, int hi) { return (r & 3) + 8 * (r >> 2) + 4 * hi; }
__device__ __forceinline__ s16x4 vtr(const LAS unsigned char* p) { typedef short v4i16_t __attribute__((ext_vector_type(4))); return __builtin_bit_cast(s16x4, __builtin_amdgcn_ds_read_tr16_b64_v4i16((LAS v4i16_t*)p)); }

__device__ __forceinline__ void unit(const AttArgs& a, int b, int h, int qb, float lam, LAS unsigned char* lds) {
    const int tid = threadIdx.x, lane = tid & 63, w = __builtin_amdgcn_readfirstlane(tid >> 6), r32 = lane & 31, hi = lane >> 5;
    const int mp = w >> 2, wq = w & 3;
    const size_t rowbase = (size_t)b * SEQ;
    const int tq = qb * 128 + wq * 32 + r32;
    const int cw = 2 * qb + (wq >> 1);
    const float sig = __builtin_amdgcn_exp2f(-2.0f * (float)(h + 1)) * LOG2E;
    bf16x8 qr[4];
    { const bf16* Qp = a.ACT + (rowbase + tq) * PITCH + C_Q + h * 128 + mp * 64 + hi * 8;
#pragma unroll
      for (int d0 = 0; d0 < 4; ++d0) qr[d0] = *(const bf16x8*)(Qp + 16 * d0); }
    const bf16* Ksrc = a.ACT + (rowbase + lane) * PITCH + C_K + h * 128 + (w >> 2) * 64 + 16 * (w & 3);
    const int kdst = (w >> 2) * 8192 + (w & 3) * 2048;
    const bf16* Vsrc = a.ACT + (rowbase + (lane >> 2)) * PITCH + C_V + h * 128 + 8 * (lane & 3);
    const int vq0 = (2 * w) & 3, vblk = (2 * w) >> 2;
    const int vdst = KBYTES + vblk * 4096 + vq0 * 1024;
#define ATT_DMA(j, bufo) do { _Pragma("unroll") for (int i_ = 0; i_ < 2; ++i_) { \
        __builtin_amdgcn_global_load_lds((const unsigned*)(Ksrc + (size_t)(64 * (j)) * PITCH + 8 * i_), (LAS unsigned*)(lds + (bufo) + kdst + i_ * 1024), 16, 0, 0); \
        __builtin_amdgcn_global_load_lds((const unsigned*)(Vsrc + (size_t)(64 * (j) + 16 * (vq0 + i_)) * PITCH + 32 * vblk), (LAS unsigned*)(lds + (bufo) + vdst + i_ * 1024), 16, 0, 0); } } while (0)
#define ATT_SYNC() do { asm volatile("s_waitcnt vmcnt(0)" ::: "memory"); __syncthreads(); } while (0)
    float mref = 0.f, l = 0.f;
    f32x16 o[4];
#pragma unroll
    for (int i = 0; i < 4; ++i)
#pragma unroll
        for (int r = 0; r < 16; ++r) o[i][r] = 0.f;
    const int jmax = 2 * qb + 1;
    ATT_DMA(jmax, 0); ATT_SYNC();
    int cur = 0;
    for (int j = jmax; j >= 0; --j) {
        if (j > 0) ATT_DMA(j - 1, (cur ^ 1) * BUF);
        if (j <= cw) {
            const bool first = (j == cw);
            f32x16 p0, p1;
            const float sb = (float)(64 * j + 4 * hi - tq);
            if (first) {
#pragma unroll
                for (int r = 0; r < 16; ++r) { const float c = (float)((r & 3) + 8 * (r >> 2)); p0[r] = -sig * __builtin_fabsf(sb + c); p1[r] = -sig * __builtin_fabsf(sb + c + 32.0f); }
            } else {
                const float base = __builtin_fmaf(sig, sb, -mref);
#pragma unroll
                for (int r = 0; r < 16; ++r) { const float c = (float)((r & 3) + 8 * (r >> 2)); p0[r] = __builtin_fmaf(sig, c, base); p1[r] = __builtin_fmaf(sig, c + 32.0f, base); }
            }
            const LAS unsigned char* Kb = lds + cur * BUF + mp * 8192 + hi * 1024 + r32 * 16;
#pragma unroll
            for (int d0 = 0; d0 < 4; ++d0) {
                const bf16x8 a0 = *(const LAS bf16x8*)(Kb + d0 * 2048), a1 = *(const LAS bf16x8*)(Kb + d0 * 2048 + 512);
                p0 = __builtin_amdgcn_mfma_f32_32x32x16_bf16(a0, qr[d0], p0, 0, 0, 0);
                p1 = __builtin_amdgcn_mfma_f32_32x32x16_bf16(a1, qr[d0], p1, 0, 0, 0);
            }
            float mx;
            { float a = MAX3(p0[0], p0[1], p1[0]), b = MAX3(p0[2], p0[3], p1[1]); a = MAX3(a, p1[2], p1[3]);
#pragma unroll
              for (int r = 4; r < 16; r += 4) { a = MAX3(a, p0[r], p0[r + 1]); b = MAX3(b, p0[r + 2], p0[r + 3]); a = MAX3(a, p1[r], p1[r + 1]); b = MAX3(b, p1[r + 2], p1[r + 3]); }
              mx = fmaxf(a, b);
              const auto rr = __builtin_amdgcn_permlane32_swap(__float_as_uint(mx), __float_as_uint(mx), false, false);
              mx = fmaxf(__uint_as_float(rr[0]), __uint_as_float(rr[1])); }
            float dl = 0.f;
            if (first || __any(mx > ATT_THR)) {
                dl = first ? mx : fmaxf(mx, 0.f);
                mref += dl;
#pragma unroll
                for (int r = 0; r < 16; ++r) { p0[r] -= dl; p1[r] -= dl; }
                if (!first) {
                    const float f = __builtin_amdgcn_exp2f(-dl); l *= f;
#pragma unroll
                    for (int i = 0; i < 4; ++i)
#pragma unroll
                        for (int r = 0; r < 16; ++r) o[i][r] *= f;
                }
            }
            float ps = 0.f;
#pragma unroll
            for (int r = 0; r < 16; ++r) { p0[r] = __builtin_amdgcn_exp2f(p0[r]); p1[r] = __builtin_amdgcn_exp2f(p1[r]); ps += p0[r] + p1[r]; }
            l += ps;
            u32x4 pw[4];
#pragma unroll
            for (int q = 0; q < 4; ++q) { pw[0][q] = pk2(p0[2 * q], p0[2 * q + 1]); pw[1][q] = pk2(p0[8 + 2 * q], p0[8 + 2 * q + 1]); pw[2][q] = pk2(p1[2 * q], p1[2 * q + 1]); pw[3][q] = pk2(p1[8 + 2 * q], p1[8 + 2 * q + 1]); }
            const unsigned vb = (unsigned)(uintptr_t)(lds + cur * BUF + KBYTES) + ((lane >> 4) & 1) * 32 + (lane & 3) * 8 + (4 * hi + ((lane & 15) >> 2)) * 64;
#pragma unroll
            for (int blk = 0; blk < 4; ++blk) {
                s16x4 lo[4], hh[4];
#pragma unroll
                for (int s = 0; s < 4; ++s) {
                    asm volatile("ds_read_b64_tr_b16 %0, %1 offset:%c2" : "=&v"(lo[s]) : "v"(vb), "i"(blk * 4096 + s * 1024) : "memory");
                    asm volatile("ds_read_b64_tr_b16 %0, %1 offset:%c2" : "=&v"(hh[s]) : "v"(vb), "i"(blk * 4096 + s * 1024 + 512) : "memory");
                }
                asm volatile("s_waitcnt lgkmcnt(0)" ::: "memory"); __builtin_amdgcn_sched_barrier(0);
#pragma unroll
                for (int s = 0; s < 4; ++s) {
                    const bf16x8 vf = (bf16x8){lo[s][0], lo[s][1], lo[s][2], lo[s][3], hh[s][0], hh[s][1], hh[s][2], hh[s][3]};
                    o[blk] = __builtin_amdgcn_mfma_f32_32x32x16_bf16(vf, __builtin_bit_cast(bf16x8, pw[s]), o[blk], 0, 0, 0);
                }
            }
        }
        ATT_SYNC();
        cur ^= 1;
    }
#undef ATT_DMA
#undef ATT_SYNC
    l += __shfl_xor(l, 32);
    const float inv = 1.0f / l;
    LAS float* X = (LAS float*)(lds + wq * 16384) + lane;
    if (mp == 1) {
#pragma unroll
        for (int i = 0; i < 4; ++i)
#pragma unroll
            for (int r = 0; r < 16; ++r) X[(i * 16 + r) * 64] = o[i][r] * inv;
    }
    __syncthreads();
    if (mp == 0) {
        float ss = 0.f;
#pragma unroll
        for (int i = 0; i < 4; ++i)
#pragma unroll
            for (int r = 0; r < 16; ++r) { const float v = o[i][r] * inv - lam * X[(i * 16 + r) * 64]; o[i][r] = v; ss += v * v; }
        ss += __shfl_xor(ss, 32);
        const float rs = (1.0f / sqrtf(ss * (1.0f / 128.0f) + EPS)) * (1.0f - LAMBDA_INIT);
        bf16* dst = a.A2 + (rowbase + tq) * DM + 512 + h * 128; const bf16* za = a.ACT + (rowbase + tq) * PITCH + C_ZA + h * 128;
#pragma unroll
        for (int i = 0; i < 4; ++i)
#pragma unroll
            for (int g4 = 0; g4 < 4; ++g4) {
                const int dv0 = 32 * i + 8 * g4 + 4 * hi;
                const f32x4 gv = *(const f32x4*)(a.subg + dv0); const u32x2 z = *(const u32x2*)(za + dv0);
                u32x2 ow;
                ow.x = pk2(o[i][4 * g4 + 0] * rs * gv[0] * bf_lo(z.x), o[i][4 * g4 + 1] * rs * gv[1] * bf_hi(z.x));
                ow.y = pk2(o[i][4 * g4 + 2] * rs * gv[2] * bf_lo(z.y), o[i][4 * g4 + 3] * rs * gv[3] * bf_hi(z.y));
                *(u32x2*)(dst + dv0) = ow;
            }
    }
    __syncthreads();
}
__device__ __forceinline__ void phase(const AttArgs& a, LAS unsigned char* lds, int G) {
    const float lam = a.lam[0];
    const int bx = blockIdx.x, vcu = (G % 8 == 0) ? (bx % 8) * (G / 8) + bx / 8 : bx;
    for (int idx = vcu; idx < 1024; idx += G) {
        const int bh = (idx & 255) >> 3, s = idx & 7, k = idx >> 8;
        const int qb = (k == 0) ? s : (k == 1) ? 15 - s : (k == 2) ? 16 + s : 31 - s;
        unit(a, bh >> 2, bh & 3, qb, lam, lds);
    }
}
}

__device__ __forceinline__ void final_phase(const float* x, const float* g_post, const float* sumsq, const float* oin, float* out, int wave, int lane, int G) {
    const int gw = blockIdx.x * 8 + wave, NGW = G * 8;
    f32x4 gp[4];
#pragma unroll
    for (int j = 0; j < 4; ++j) gp[j] = ((const f32x4*)g_post)[lane + 64 * j];
    for (int m = gw; m < TOK; m += NGW) {
        const float rstd = 1.0f / sqrtf(sumsq[m] * (1.0f / DM) + EPS);
        const f32x4* xr = (const f32x4*)(x + (size_t)m * DM) + lane; const f32x4* irow = (const f32x4*)(oin + (size_t)m * DM) + lane; f32x4* orow = (f32x4*)(out + (size_t)m * DM) + lane;
#pragma unroll
        for (int j = 0; j < 4; ++j) { const f32x4 xv = xr[64 * j], ov = irow[64 * j]; orow[64 * j] = xv + ov * rstd * gp[j]; }
    }
}

#define GAS __attribute__((address_space(1)))
#define XB_TMO      128
#define XB_XCNT(j)  (256  + 64 * (j))
#define XB_XSUB(j)  (1280 + 64 * (j))
#define XB_XGEN(j)  (2304 + 64 * (j))
#define XB_TOP      3328
#define XB_TOPGEN   3392
#define XCD_BAR_WORDS 3456
#define XB_SPIN_CAP (1u << 18)

__device__ __forceinline__ unsigned xb_ld(unsigned* p)              { return __hip_atomic_load(p, __ATOMIC_RELAXED, __HIP_MEMORY_SCOPE_AGENT); }
__device__ __forceinline__ unsigned xb_add(unsigned* p, unsigned v) { return __hip_atomic_fetch_add(p, v, __ATOMIC_RELAXED, __HIP_MEMORY_SCOPE_AGENT); }
__device__ __forceinline__ unsigned xb_xcc_id() { return (unsigned)__builtin_amdgcn_s_getreg((3 << 11) | 20) & 0xFu; }
#define XB_SPIN(cond, bar) do { unsigned _sp = 0; while (cond) { __builtin_amdgcn_s_sleep(1); \
    if ((++_sp & 255u) == 0u) { if (xb_ld(&(bar)[XB_TMO])) break; if (_sp > XB_SPIN_CAP) { atomicAdd(&(bar)[XB_TMO], 1u); break; } } } } while (0)

struct XcdBarrier {
    unsigned* bar; unsigned x;
    volatile LAS unsigned* st;
};

__device__ __forceinline__ XcdBarrier xcd_barrier_post(unsigned* bar, volatile LAS unsigned* st) {
    XcdBarrier b; b.bar = bar; b.x = xb_xcc_id(); b.st = st;
    if (threadIdx.x == 0) (void)xb_add(&bar[XB_XCNT(b.x)], 1u);
    return b;
}
__device__ __forceinline__ void xcd_barrier_complete(unsigned* bar, unsigned x, unsigned& nloc, unsigned& nx) {
    const unsigned G = gridDim.x * gridDim.y * gridDim.z;
    unsigned sum, cnt, mine, sp = 0u;
    for (;;) {
        sum = 0u; cnt = 0u; mine = 0u;
#pragma unroll
        for (unsigned j = 0; j < 16; ++j) { const unsigned c = xb_ld(&bar[XB_XCNT(j)]); sum += c; cnt += (c > 0u) ? 1u : 0u; mine = (j == x) ? c : mine; }
        if (sum == G) break;
        __builtin_amdgcn_s_sleep(1);
        if ((++sp & 255u) == 0u) { if (xb_ld(&bar[XB_TMO])) break; if (sp > XB_SPIN_CAP) { atomicAdd(&bar[XB_TMO], 1u); break; } }
    }
    nloc = mine > 0u ? mine : 1u; nx = cnt > 0u ? cnt : 1u;
}

__device__ __forceinline__ void xcd_barrier(const XcdBarrier& b) {
    asm volatile("s_waitcnt vmcnt(0)" ::: "memory");
    __syncthreads();
    if (threadIdx.x == 0) {
        unsigned* bar = b.bar;
        __builtin_amdgcn_s_waitcnt(0);
        unsigned nloc = b.st[0], nx = b.st[1];
        if (nloc == 0u) { xcd_barrier_complete(bar, b.x, nloc, nx); b.st[0] = nloc; b.st[1] = nx; }
        const unsigned old = xb_add(&bar[XB_XSUB(b.x)], 1u);
        const unsigned gen = old / nloc;
        if (old + 1u == (gen + 1u) * nloc) {
            __builtin_amdgcn_fence(__ATOMIC_RELEASE, "agent");
            asm volatile("s_waitcnt vmcnt(0)" ::: "memory");
            const unsigned og = xb_add(&bar[XB_TOP], 1u);
            const unsigned tg = og / nx;
            if (og + 1u == (tg + 1u) * nx) xb_add(&bar[XB_TOPGEN], 1u);
            else XB_SPIN(xb_ld(&bar[XB_TOPGEN]) == tg, bar);
            __builtin_amdgcn_fence(__ATOMIC_ACQUIRE, "agent");
            xb_add(&bar[XB_XGEN(b.x)], 1u);
            asm volatile("s_waitcnt vmcnt(0)" ::: "memory");
        } else {
            XB_SPIN(xb_ld(&bar[XB_XGEN(b.x)]) == gen, bar);
            __builtin_amdgcn_fence(__ATOMIC_ACQUIRE, "agent");
            asm volatile("s_waitcnt vmcnt(0)" ::: "memory");
        }
    }
    __syncthreads();
}

#ifndef REP_ATT
#define REP_ATT 1
#endif
#ifndef REP_P0
#define REP_P0 1
#endif
#ifndef REP_P1
#define REP_P1 1
#endif
#ifndef REP_CONV
#define REP_CONV 1
#endif
#ifndef REP_P3
#define REP_P3 1
#endif
#ifndef REP_P4
#define REP_P4 1
#endif
#ifndef REP_P5
#define REP_P5 1
#endif
#ifndef USE_CG_SYNC
#define USE_CG_SYNC 0
#endif
#ifndef MK_N_LAUNCHES
#define MK_N_LAUNCHES 1
#endif
template <int R> struct RepOrder {
    pg8::StaticOrder S;
    __device__ __forceinline__ bool next(int i, pg8::Unit& u) const { const int nU = (S.nwg - S.c + S.G - 1) / S.G; if (i >= R * nU) return false; return S.next(i % nU, u); }
    __device__ __forceinline__ void a_ready(const pg8::Unit&) const {}
    __device__ __forceinline__ void done(const pg8::Unit&) const {}
};
struct Args { const float* in[16]; float* out; unsigned char* ws; int ph_lo, ph_hi; };
__global__ void __launch_bounds__(512, 2) fwd_kernel(Args args) {
    extern __shared__ __attribute__((aligned(16))) unsigned char lds_raw[];
    LAS unsigned char* lds = (LAS unsigned char*)lds_raw;
    const int tid = threadIdx.x, lane = tid & 63, wave = __builtin_amdgcn_readfirstlane(tid >> 6), G = gridDim.x;
    unsigned char* ws = args.ws;
    bf16* WIN = (bf16*)(ws + WS_WIN); bf16* WBR = (bf16*)(ws + WS_WBR); bf16* WO = (bf16*)(ws + WS_WO);
    bf16* XN = (bf16*)(ws + WS_XN); bf16* MIX = XN; bf16* ACT = (bf16*)(ws + WS_ACT); bf16* A2 = (bf16*)(ws + WS_A2);
    float* LAM = (float*)(ws + WS_CTL); float* SUMSQ = (float*)(ws + WS_SUMSQ);
    const int lo = args.ph_lo, hi = args.ph_hi;
#define IN(k) (lo <= (k) && (k) < hi)
#ifdef DIAG_PHASE
    unsigned long long ts_[8]; int nts_ = 0;
#define STAMP() do { ts_[nts_++] = __builtin_amdgcn_s_memrealtime(); } while (0)
#else
#define STAMP() do {} while (0)
#endif
#if USE_CG_SYNC
#define SEAM(k) do { if (IN(k) && IN((k) + 1)) { cg::this_grid().sync(); } STAMP(); } while (0)
#else
    { volatile LAS unsigned* st = (volatile LAS unsigned*)(lds + 131072); if (tid < 2) st[tid] = 0u; __syncthreads(); }
    XcdBarrier bar = xcd_barrier_post((unsigned*)(ws + WS_BAR), (volatile LAS unsigned*)(lds + 131072));
#define SEAM(k) do { if (IN(k) && IN((k) + 1)) { xcd_barrier(bar); } STAMP(); } while (0)
#endif
    STAMP();
    if (IN(0)) {
        P0Args a{args.in[0], args.in[1], args.in[6], args.in[12], args.in[13], args.in[14], args.in[7], args.in[8], args.in[9], args.in[10], WIN, WBR, WO, XN, LAM};
        for (int rep = 0; rep < REP_P0; ++rep) p0_prologue(a, lds, wave, lane, G);
    }
    SEAM(0);
    if (IN(1)) {
        pg8::Gemm g{XN, WIN, TOK, DIN, DM}; pg8::StaticOrder S; S.init(TOK, DIN, G, (int)blockIdx.x);
        pg8::EpiIn E{ACT};
        pg8::gemm_phase<pg8::EpiIn, RepOrder<REP_P1>, true, true>(lds, g, RepOrder<REP_P1>{S}, E);
    }
    SEAM(1);
    if (IN(2)) {
        ConvArgs c{ACT, A2, args.in[2], args.in[3], args.in[4], args.in[5]};
        for (int rep = 0; rep < REP_CONV; ++rep) conv_phase(c, lds, wave, lane, G);
        AttArgs a{ACT, A2, args.in[11], LAM};
        for (int rep = 0; rep < REP_ATT; ++rep) att::phase(a, lds, G);
    }
    SEAM(2);
    if (IN(3)) {
        pg8::Gemm g{A2, WBR, TOK, DM, DM}; pg8::StaticOrder S; S.init(TOK, DM, G, (int)blockIdx.x);
        pg8::EpiMix E{ACT, MIX};
        pg8::gemm_phase<pg8::EpiMix, RepOrder<REP_P3>, true, true, 8>(lds, g, RepOrder<REP_P3>{S}, E);
    }
    SEAM(3);
    if (IN(4)) {
        pg8::Gemm g{MIX, WO, TOK, DM, DM}; pg8::StaticOrder S; S.init(TOK, DM, G, (int)blockIdx.x);
        pg8::EpiOut E{args.out, SUMSQ, 1.0f / REP_P4};
        pg8::gemm_phase<pg8::EpiOut, RepOrder<REP_P4>, true, true>(lds, g, RepOrder<REP_P4>{S}, E);
    }
    SEAM(4);
    if (IN(5)) {
        if (REP_P5 > 1) final_phase(args.in[0], args.in[15], SUMSQ, args.out, (float*)ACT, wave, lane, G);
        final_phase(args.in[0], args.in[15], SUMSQ, args.out, args.out, wave, lane, G);
    }
#ifdef DIAG_PHASE
    STAMP();
    cg::this_grid().sync();
    if (blockIdx.x == 0 && tid == 0) { const int k = DIAG_PHASE; const float us = (k < 6) ? (float)(ts_[k + 1] - ts_[k]) * 0.01f : (float)(ts_[6] - ts_[0]) * 0.01f; args.out[0] = us; }
#endif
#undef IN
#undef SEAM
}

extern "C" void kernel_launch(void* const* d_in, const int* in_sizes, int n_in, void* d_out, int out_size, void* d_ws, size_t ws_size, hipStream_t stream) {
    static int grid = 0;
    if (grid == 0) {
        if (n_in != 16 || in_sizes[0] != TOK * DM || out_size != TOK * DM || ws_size < WS_END) { fprintf(stderr, "kernel_launch: unexpected shapes (n_in %d, in0 %d, out %d, ws %zu)\n", n_in, n_in > 0 ? in_sizes[0] : -1, out_size, ws_size); grid = -1; return; }
        int dev = 0, cus = 0, per_cu = 0;
        if (hipGetDevice(&dev) != hipSuccess || hipDeviceGetAttribute(&cus, hipDeviceAttributeMultiprocessorCount, dev) != hipSuccess) { grid = -1; return; }
        if (hipFuncSetAttribute((const void*)fwd_kernel, hipFuncAttributeMaxDynamicSharedMemorySize, LDS_BYTES) != hipSuccess) { fprintf(stderr, "kernel_launch: hipFuncSetAttribute failed\n"); grid = -1; return; }
        if (hipOccupancyMaxActiveBlocksPerMultiprocessor(&per_cu, (const void*)fwd_kernel, 512, LDS_BYTES) != hipSuccess || per_cu < 1) { fprintf(stderr, "kernel_launch: occupancy query failed (%d)\n", per_cu); per_cu = 1; }
        (void)hipGetLastError();
        grid = cus;
    }
    if (grid < 0) return;
    (void)hipMemsetAsync((char*)d_ws + WS_CTL, 0, CTL_ZERO_BYTES, stream);
    Args a{};
    for (int i = 0; i < 16; ++i) a.in[i] = (const float*)d_in[i];
    a.out = (float*)d_out; a.ws = (unsigned char*)d_ws;
#if MK_N_LAUNCHES == 1
    a.ph_lo = 0; a.ph_hi = 6;
    void* kargs[] = {&a};
    hipError_t e = hipLaunchCooperativeKernel((const void*)fwd_kernel, dim3(grid), dim3(512), kargs, LDS_BYTES, stream);
    if (e != hipSuccess) fprintf(stderr, "kernel_launch: cooperative launch failed: %s (grid %d)\n", hipGetErrorString(e), grid);
#else
    for (int p = 0; p < 6; ++p) {
        a.ph_lo = p; a.ph_hi = p + 1;
        hipLaunchKernelGGL(fwd_kernel, dim3(grid), dim3(512), LDS_BYTES, stream, a);
    }
#endif
}
```
